# Optimizing an MI355X kernel written in HIP

```python
import jax
import jax.numpy as jnp
from jax import lax
import numpy as np

D_MODEL = 1024
BATCH = 4
SEQ = 4096
DEPTH = 2

GRID_W = 64
CTX_LEN = 256
N_HEADS = 8
HEAD_DIM = 64
ATTN_W = N_HEADS * HEAD_DIM
WIN_ROWS_MAX = 8
WIN_COLS = 16
FOURIER_GROUPS = 4
FOURIER_GROUP_DIM = 64
FOURIER_W = FOURIER_GROUPS * FOURIER_GROUP_DIM
CONV_W = 256
CONV_K = 31
N_BRANCHES = 3
NORM_EPS = 1e-6
IN_SIZES = (ATTN_W,) * 4 + (FOURIER_W,) * 2 + (CONV_W,) * 3 + (D_MODEL,) * N_BRANCHES
IN_W = sum(IN_SIZES)

kernel_name = 'hybrid_natten_fourier_conformer_prefix_block'


def rms_norm(x, g):
    xf = x.astype(jnp.float32)
    y = xf * lax.rsqrt(jnp.mean(xf * xf, axis=-1, keepdims=True) + NORM_EPS)
    return (y * g.astype(jnp.float32)).astype(x.dtype)


def layer_norm(x, g, b):
    xf = x.astype(jnp.float32)
    xc = xf - jnp.mean(xf, axis=-1, keepdims=True)
    var = jnp.mean(xc * xc, axis=-1, keepdims=True)
    y = xc * lax.rsqrt(var + NORM_EPS) * g.astype(jnp.float32) + b.astype(jnp.float32)
    return y.astype(x.dtype)


def split_in(p):
    return jnp.split(p, np.cumsum(IN_SIZES)[:-1].tolist(), axis=-1)


def heads(t):
    return t.reshape(t.shape[0], t.shape[1], N_HEADS, HEAD_DIM)


def context_attention(q, k, v):
    s = jnp.einsum('bqhd,bkhd->bhqk', q, k, preferred_element_type=jnp.float32) * (HEAD_DIM ** -0.5)
    p = jax.nn.softmax(s, axis=-1).astype(v.dtype)
    return jnp.einsum('bhqk,bkhd->bqhd', p, v)


def neighbourhood_attention(q, k, v, k_ctx, v_ctx, rpb):
    B, S, H, Dh = q.shape
    rows = S // GRID_W
    kr = min(WIN_ROWS_MAX, rows)
    nw = kr * WIN_COLS
    scale = Dh ** -0.5
    cols = jnp.arange(GRID_W)
    col_start = jnp.clip(cols - WIN_COLS // 2, 0, GRID_W - WIN_COLS)
    key_cols = col_start[:, None] + jnp.arange(WIN_COLS)
    dc_idx = key_cols - cols[:, None] + (WIN_COLS - 1)
    q_rows = jnp.moveaxis(q.reshape(B, rows, GRID_W, H, Dh), 1, 0)

    def one_row(args):
        r, q_r = args
        row_start = jnp.clip(r - kr // 2, 0, rows - kr)
        key_rows = row_start + jnp.arange(kr)
        tok = (key_rows[None, :, None] * GRID_W + key_cols[:, None, :]).reshape(-1)
        k_w = jnp.take(k, tok, axis=1).reshape(B, GRID_W, nw, H, Dh)
        v_w = jnp.take(v, tok, axis=1).reshape(B, GRID_W, nw, H, Dh)
        dr_idx = key_rows - r + (WIN_ROWS_MAX - 1)
        bias = rpb[:, dr_idx[None, :, None], dc_idx[:, None, :]].reshape(H, GRID_W, nw)
        s_win = jnp.einsum('bqhd,bqkhd->bhqk', q_r, k_w, preferred_element_type=jnp.float32) * scale + bias
        s_ctx = jnp.einsum('bqhd,blhd->bhql', q_r, k_ctx, preferred_element_type=jnp.float32) * scale
        p = jax.nn.softmax(jnp.concatenate([s_win, s_ctx], axis=-1), axis=-1).astype(v.dtype)
        return (jnp.einsum('bhqk,bqkhd->bqhd', p[..., :nw], v_w)
                + jnp.einsum('bhql,blhd->bqhd', p[..., nw:], v_ctx))

    out = lax.map(one_row, (jnp.arange(rows), q_rows))
    return jnp.moveaxis(out, 0, 1).reshape(B, S, H, Dh)


def fourier_mix(u):
    B, N, _ = u.shape
    ug = u.astype(jnp.float32).reshape(B, N, FOURIER_GROUPS, FOURIER_GROUP_DIM)
    f = jnp.fft.fftn(ug, axes=(1, 3), norm='ortho').real
    return f.reshape(B, N, FOURIER_W).astype(u.dtype)


def conv_module(c_a, c_b, w_dw, b_dw, ln_g, ln_b, w_pw):
    u = c_a * jax.nn.sigmoid(c_b)
    u = lax.conv_general_dilated(u, w_dw[:, None, :], window_strides=(1,),
                                 padding=[(CONV_K // 2, CONV_K // 2)],
                                 dimension_numbers=('NWC', 'WIO', 'NWC'),
                                 feature_group_count=CONV_W) + b_dw
    u = jax.nn.silu(layer_norm(u, ln_g, ln_b))
    return u @ w_pw


def branch_tail(attn_o, g_a, u_f, g_f, c_a, c_b, g_c, s_a, s_f, s_c,
                w_four, conv_dw, conv_db, ln_g, ln_b, w_pw, p_attn, p_four, p_conv, w_out):
    B, N = attn_o.shape[:2]
    y_a = (attn_o.reshape(B, N, ATTN_W) * jax.nn.silu(g_a)) @ p_attn
    y_f = ((fourier_mix(u_f) @ w_four) * jax.nn.silu(g_f)) @ p_four
    y_c = (conv_module(c_a, c_b, conv_dw, conv_db, ln_g, ln_b, w_pw) * jax.nn.silu(g_c)) @ p_conv
    merged = jax.nn.sigmoid(s_a) * y_a + jax.nn.sigmoid(s_f) * y_f + jax.nn.sigmoid(s_c) * y_c
    return merged @ w_out


def setup_inputs(seed: int = 0) -> dict:
    key = jax.random.key(seed)
    ks = jax.random.split(key, 20)

    def nrm(k, shape, s):
        return jax.random.normal(k, shape, jnp.float32) * s

    return {
        'x': nrm(ks[0], (BATCH, SEQ, D_MODEL), 1.0),
        'c': nrm(ks[1], (BATCH, D_MODEL), 1.0),
        'ctx': nrm(ks[2], (BATCH, CTX_LEN, D_MODEL), 1.0),
        'c_ctx': nrm(ks[3], (D_MODEL,), 1.0),
        'w_mod': nrm(ks[4], (DEPTH, D_MODEL, 3 * D_MODEL), 0.5 * D_MODEL ** -0.5),
        'b_mod': nrm(ks[5], (DEPTH, 3 * D_MODEL), 0.01),
        'g_pre': 1.0 + nrm(ks[6], (DEPTH, D_MODEL), 0.02),
        'g_post': 1.0 + nrm(ks[7], (DEPTH, D_MODEL), 0.02),
        'w_in': nrm(ks[8], (DEPTH, D_MODEL, IN_W), D_MODEL ** -0.5),
        'rpb': nrm(ks[9], (DEPTH, N_HEADS, 2 * WIN_ROWS_MAX - 1, 2 * WIN_COLS - 1), 0.5),
        'w_four': nrm(ks[10], (DEPTH, FOURIER_W, FOURIER_W), FOURIER_W ** -0.5),
        'conv_dw': nrm(ks[11], (DEPTH, CONV_K, CONV_W), CONV_K ** -0.5),
        'conv_db': nrm(ks[12], (DEPTH, CONV_W), 0.01),
        'conv_ln_g': 1.0 + nrm(ks[13], (DEPTH, CONV_W), 0.02),
        'conv_ln_b': nrm(ks[14], (DEPTH, CONV_W), 0.01),
        'w_pw': nrm(ks[15], (DEPTH, CONV_W, CONV_W), CONV_W ** -0.5),
        'p_attn': nrm(ks[16], (DEPTH, ATTN_W, D_MODEL), ATTN_W ** -0.5),
        'p_four': nrm(ks[17], (DEPTH, FOURIER_W, D_MODEL), FOURIER_W ** -0.5),
        'p_conv': nrm(ks[18], (DEPTH, CONV_W, D_MODEL), CONV_W ** -0.5),
        'w_out': nrm(ks[19], (DEPTH, D_MODEL, D_MODEL), D_MODEL ** -0.5),
    }


def reference(x, c, ctx, c_ctx, w_mod, b_mod, g_pre, g_post, w_in, rpb, w_four,
              conv_dw, conv_db, conv_ln_g, conv_ln_b, w_pw, p_attn, p_four, p_conv, w_out):
    sc = jax.nn.silu(c)
    sc_ctx = jax.nn.silu(c_ctx)
    for l in range(DEPTH):
        tail_w = (w_four[l], conv_dw[l], conv_db[l], conv_ln_g[l], conv_ln_b[l], w_pw[l],
                  p_attn[l], p_four[l], p_conv[l], w_out[l])
        shift, scale, gate = jnp.split(sc @ w_mod[l] + b_mod[l], 3, axis=-1)
        shift_c, scale_c, gate_c = jnp.split(sc_ctx @ w_mod[l] + b_mod[l], 3, axis=-1)
        h = rms_norm(x, g_pre[l]) * (1.0 + scale[:, None, :]) + shift[:, None, :]
        hc = rms_norm(ctx, g_pre[l]) * (1.0 + scale_c) + shift_c
        update_ctx = l < DEPTH - 1
        if update_ctx:
            qc, kc, vc, *rest_c = split_in(hc @ w_in[l])
        else:
            kc, vc = jnp.split(hc @ w_in[l][:, ATTN_W:3 * ATTN_W], 2, axis=-1)
        kc, vc = heads(kc), heads(vc)
        q, k, v, *rest = split_in(h @ w_in[l])
        attn = neighbourhood_attention(heads(q), heads(k), heads(v), kc, vc, rpb[l])
        y = branch_tail(attn, *rest, *tail_w)
        x = x + gate[:, None, :] * rms_norm(y, g_post[l])
        if update_ctx:
            attn_c = context_attention(heads(qc), kc, vc)
            yc = branch_tail(attn_c, *rest_c, *tail_w)
            ctx = ctx + gate_c * rms_norm(yc, g_post[l])
    return x
```

```cpp
#include <hip/hip_runtime.h>
#include <cstdio>
#include <cstdint>

#define LAS __attribute__((address_space(3)))
typedef unsigned short bf16;
typedef short bf16x8 __attribute__((ext_vector_type(8)));
typedef float f32x4 __attribute__((ext_vector_type(4)));
typedef float f32x16 __attribute__((ext_vector_type(16)));
typedef unsigned u32x4 __attribute__((ext_vector_type(4)));
typedef unsigned u32x2 __attribute__((ext_vector_type(2)));

constexpr int D = 1024, NB = 4, SEQ = 4096, CTX = 256, NH = 8;
constexpr int ML = NB * SEQ, MC = NB * CTX, MT = ML + MC;
constexpr int INW = 6400, NIN = 6656;
constexpr int OUF = 2048, OCA = 2560, OCB = 2816;
constexpr float EPS = 1e-6f;
constexpr float QSCALE = 0.125f * 1.44269504088896f;
constexpr float LOG2E = 1.44269504088896f;

constexpr size_t KiB = 1024, MiB = 1024 * 1024;
constexpr size_t WS_CTL = 0;
constexpr size_t WS_MODV = 1 * MiB;
constexpr size_t WS_WCS = WS_MODV + 128 * KiB;
constexpr size_t WS_D1T = WS_WCS + 1 * MiB;
constexpr size_t WS_E2T = WS_D1T + 32 * KiB;
constexpr size_t WS_TW = WS_E2T + 16 * KiB;
constexpr size_t WS_DCTX = WS_TW + 32 * KiB;
constexpr size_t WS_SSQ = WS_DCTX + 256 * KiB;
constexpr size_t WS_CTX1 = WS_SSQ + 1088 * KiB;
constexpr size_t WS_BTIN = 8 * MiB;
constexpr size_t WS_BTCAT = WS_BTIN + 26 * MiB;
constexpr size_t WS_BTOUT = WS_BTCAT + 4 * MiB;
constexpr size_t WS_BTPW = WS_BTOUT + 4 * MiB;
constexpr size_t WS_XN = 43 * MiB;
constexpr size_t WS_Q = WS_XN + 34 * MiB;
constexpr size_t WS_K = WS_Q + 17 * MiB;
constexpr size_t WS_MERGED = WS_Q;
constexpr size_t WS_VTL = WS_K + 17 * MiB;
constexpr size_t WS_VTC = WS_VTL + 16 * MiB;
constexpr size_t WS_GA = WS_VTC + 1 * MiB;
constexpr size_t WS_Y = WS_VTL;
constexpr size_t WS_UFL = WS_GA + 17 * MiB;
constexpr size_t WS_ZT = WS_UFL + 16 * MiB;
constexpr size_t WS_GF = WS_ZT + 1 * MiB;
constexpr size_t WS_GLU = WS_GF + 8704 * KiB;
constexpr size_t WS_GC = WS_GLU + 8704 * KiB;
constexpr size_t WS_S = WS_GC + 8704 * KiB;
constexpr size_t WS_MERGEDC = WS_S + 51 * MiB;
constexpr size_t WS_YC = WS_MERGEDC + 2 * MiB;
constexpr size_t WS_END = WS_YC + 2 * MiB;
static_assert(WS_CTX1 + 4 * MiB <= WS_BTIN && WS_BTPW + 256 * KiB <= WS_XN && WS_END <= 256 * MiB, "ws map");

constexpr int LDS_MISC = 147456;
constexpr int LDS_BYTES = 147456 + 1024;

__device__ __forceinline__ unsigned cvt_pk_bf16(float lo, float hi) { unsigned r; asm volatile("v_cvt_pk_bf16_f32 %0, %1, %2" : "=v"(r) : "v"(lo), "v"(hi)); return r; }
__device__ __forceinline__ unsigned f2bf(float f) { unsigned u = __builtin_bit_cast(unsigned, f); return (u + 0x7fffu + ((u >> 16) & 1u)) >> 16; }
__device__ __forceinline__ float bflo(unsigned u) { return __builtin_bit_cast(float, u << 16); }
__device__ __forceinline__ float bfhi(unsigned u) { return __builtin_bit_cast(float, u & 0xffff0000u); }
__device__ __forceinline__ float bf2f(bf16 b) { return __builtin_bit_cast(float, (unsigned)b << 16); }
__device__ __forceinline__ float fast_sigmoid(float v) { return __builtin_amdgcn_rcpf(1.f + __builtin_amdgcn_exp2f(-v * LOG2E)); }
__device__ __forceinline__ float fast_silu(float v) { return v * fast_sigmoid(v); }
template <int CTRL, int ROWMASK> __device__ __forceinline__ float dpp_term(float v) {
    return __builtin_bit_cast(float, __builtin_amdgcn_update_dpp(0, __builtin_bit_cast(int, v), CTRL, ROWMASK, 0xf, false));
}
__device__ __forceinline__ float wave_sum(float v) {
    v += dpp_term<0xB1, 0xf>(v);
    v += dpp_term<0x4E, 0xf>(v);
    v += dpp_term<0x141, 0xf>(v);
    v += dpp_term<0x140, 0xf>(v);
    v += dpp_term<0x142, 0xa>(v);
    v += dpp_term<0x143, 0xc>(v);
    return __builtin_bit_cast(float, __builtin_amdgcn_readlane(__builtin_bit_cast(int, v), 63));
}
#define LDS_WAIT() asm volatile("s_waitcnt lgkmcnt(0)" ::: "memory")
#define VM_WAIT() asm volatile("s_waitcnt vmcnt(0)" ::: "memory")

namespace pg8 {
constexpr int BM = 256, BK = 64, HALF = 128, HTB = HALF * BK * 2, STAGE_BYTES = 8 * HTB, NXCD = 8, WGM = 8;
__device__ __forceinline__ int lds_byte(int r, int c) { const int st = (r >> 4) * 2 + (c >> 5), rr = r & 15, cc = c & 31, ob = rr * 64 + cc * 2; return st * 1024 + (ob ^ (((ob >> 9) & 1) << 5)); }
__device__ __forceinline__ void stage_rc(int b, int& R, int& C) { const int st = b / 1024, sb = b % 1024, swz = sb ^ (((sb >> 9) & 1) << 5); R = (st >> 1) * 16 + swz / 64; C = (st & 1) * 32 + (swz % 64) / 2; }
__device__ __forceinline__ int perm32(int rho) { const int n = rho >> 4, i = rho & 15; return 8 * (i >> 2) + 4 * n + (i & 3); }

struct Unit { int pm, pn, k0, nt, tag; };
struct Gemm { const bf16* A; const bf16* Bt; int lda, ldb; };

__device__ __forceinline__ void tile_of(int L, int nM, int nN, int& pm, int& pn) {
    const int nwg = nM * nN; int wgid = L; { const int q = nwg / NXCD, r = nwg % NXCD, xcd = wgid % NXCD, off = wgid / NXCD; wgid = (xcd < r ? xcd * (q + 1) : r * (q + 1) + (xcd - r) * q) + off; }
    const int nig = WGM * nN, gid = wgid / nig, fm = gid * WGM, gsz = (nM - fm) < WGM ? (nM - fm) : WGM;
    pm = fm + ((wgid % nig) % gsz); pn = (wgid % nig) / gsz;
}

template <class Epi, class Sched>
__device__ __forceinline__ void gemm_phase(LAS unsigned char* lds, const Gemm g, const Sched& S, const Epi& E) {
    int tid_ = threadIdx.x; asm volatile("" : "+v"(tid_));
    const int tid = tid_, wid = __builtin_amdgcn_readfirstlane(tid >> 6), lane = tid & 63, wr = wid >> 2, wc = wid & 3, fr = lane & 15, fq = lane >> 4;
    unsigned voffA[2], voffB[2];
#pragma unroll
    for (int i = 0; i < 2; ++i) { int R, C; stage_rc(tid * 16 + i * 8192, R, C); const int Rb = (R & ~31) + perm32(R & 31);
        voffA[i] = (unsigned)(R * g.lda + C) * 2u; voffB[i] = (unsigned)(Rb * g.ldb + C) * 2u; }
    const size_t kstep = (size_t)(BK * 2);
    const size_t hstepA = (size_t)HALF * g.lda * 2, hstepB = (size_t)HALF * g.ldb * 2;
    const unsigned ldsw = (unsigned)wid * 1024u;
    const int aoff = lds_byte(wr * 64 + fr, fq * 8), boff = lds_byte(wc * 32 + fr, fq * 8);
#define PG8_SA(b, h) (((b) * 2 + (h)) * HTB)
#define PG8_SB(b, h) ((4 + (b) * 2 + (h)) * HTB)
#define PG8_STAGE(bufoff, gbase, voff) do { _Pragma("unroll") for (int _i = 0; _i < 2; ++_i) \
        __builtin_amdgcn_global_load_lds((const unsigned*)((const char*)(gbase) + (voff)[_i]), (LAS unsigned*)(lds + (bufoff) + ldsw + _i * 8192), 16, 0, 0); } while (0)
#define PG8_LDA(dst, b, h) do { _Pragma("unroll") for (int m = 0; m < 4; ++m) _Pragma("unroll") for (int k = 0; k < 2; ++k) dst[m][k] = *(const LAS bf16x8*)(lds + PG8_SA(b, h) + aoff + m * 2048 + k * 1024); } while (0)
#define PG8_LDB(dst, b, h) do { _Pragma("unroll") for (int n = 0; n < 2; ++n) _Pragma("unroll") for (int k = 0; k < 2; ++k) dst[n][k] = *(const LAS bf16x8*)(lds + PG8_SB(b, h) + boff + n * 2048 + k * 1024); } while (0)
#define PG8_MMA(ai, bj, At, Bt) do { __builtin_amdgcn_s_setprio(1); _Pragma("unroll") for (int m = 0; m < 4; ++m) _Pragma("unroll") for (int n = 0; n < 2; ++n) _Pragma("unroll") for (int k = 0; k < 2; ++k) \
        acc[ai][bj][m][n] = __builtin_amdgcn_mfma_f32_16x16x32_bf16(Bt[n][k], At[m][k], acc[ai][bj][m][n], 0, 0, 0); __builtin_amdgcn_s_setprio(0); } while (0)
#define PG8_WAIT_V(n) asm volatile("s_waitcnt vmcnt(" #n ")" ::: "memory")
#define PG8_WAIT_L(n) asm volatile("s_waitcnt lgkmcnt(" #n ")" ::: "memory")
#define PG8_BAR __builtin_amdgcn_s_barrier()
#define PG8_SCHED __builtin_amdgcn_sched_barrier(0)
    Unit cur, nxt; int ui = 0;
    if (!S.next(0, cur)) return;
    f32x4 acc[2][2][4][2];
#pragma unroll
    for (int a = 0; a < 2; ++a)
#pragma unroll
        for (int b = 0; b < 2; ++b)
#pragma unroll
            for (int m = 0; m < 4; ++m)
#pragma unroll
                for (int n = 0; n < 2; ++n) acc[a][b][m][n] = (f32x4){0.f, 0.f, 0.f, 0.f};
    bf16x8 At[4][2], B0[2][2], B1[2][2];
    const char* cA = (const char*)(g.A + (size_t)cur.pm * BM * g.lda + cur.k0); const char* cB = (const char*)(g.Bt + (size_t)cur.pn * BM * g.ldb + cur.k0);
    PG8_STAGE(PG8_SB(0, 0), cB, voffB); PG8_STAGE(PG8_SB(0, 1), cB + hstepB, voffB); PG8_STAGE(PG8_SA(0, 0), cA, voffA); PG8_STAGE(PG8_SA(0, 1), cA + hstepA, voffA);
    if (wr == 1) PG8_BAR;
    PG8_WAIT_V(2); PG8_BAR;
    PG8_STAGE(PG8_SB(1, 0), cB + kstep, voffB); PG8_STAGE(PG8_SA(1, 0), cA + kstep, voffA); PG8_STAGE(PG8_SB(1, 1), cB + hstepB + kstep, voffB);
    PG8_WAIT_V(6); PG8_BAR;
    for (;;) {
        const bool has_next = S.next(ui + 1, nxt);
        const char* nA = has_next ? (const char*)(g.A + (size_t)nxt.pm * BM * g.lda + nxt.k0) : cA; const char* nB = has_next ? (const char*)(g.Bt + (size_t)nxt.pn * BM * g.ldb + nxt.k0) : cB;
        const int nt = cur.nt;
        for (int t = 0; t < nt; t += 2) {
            const bool last = (t == nt - 2);
            const char* a1 = cA + (size_t)(t + 1) * kstep;
            const char* a2 = last ? nA : cA + (size_t)(t + 2) * kstep; const char* b2 = last ? nB : cB + (size_t)(t + 2) * kstep;
            const char* a3 = a2 + kstep; const char* b3 = b2 + kstep;
            PG8_LDB(B0, 0, 0); PG8_LDB(B1, 0, 1); PG8_SCHED; PG8_LDA(At, 0, 0); PG8_STAGE(PG8_SA(1, 1), a1 + hstepA, voffA);
            PG8_WAIT_V(8); PG8_WAIT_L(0); PG8_BAR; PG8_MMA(0, 0, At, B0); PG8_MMA(0, 1, At, B1); PG8_BAR; PG8_SCHED;
            PG8_LDA(At, 0, 1); PG8_STAGE(PG8_SB(0, 0), b2, voffB); PG8_STAGE(PG8_SB(0, 1), b2 + hstepB, voffB); PG8_STAGE(PG8_SA(0, 0), a2, voffA);
            PG8_WAIT_V(8); PG8_WAIT_L(0); PG8_BAR; PG8_MMA(1, 0, At, B0); PG8_MMA(1, 1, At, B1); PG8_BAR; PG8_SCHED;
            PG8_LDB(B0, 1, 0); PG8_LDB(B1, 1, 1); PG8_SCHED; PG8_LDA(At, 1, 0); PG8_STAGE(PG8_SA(0, 1), a2 + hstepA, voffA);
            PG8_WAIT_V(8); PG8_WAIT_L(0); PG8_BAR; PG8_MMA(0, 0, At, B0); PG8_MMA(0, 1, At, B1); PG8_BAR; PG8_SCHED;
            PG8_LDA(At, 1, 1); PG8_STAGE(PG8_SB(1, 0), b3, voffB); PG8_STAGE(PG8_SB(1, 1), b3 + hstepB, voffB); PG8_STAGE(PG8_SA(1, 0), a3, voffA);
            PG8_WAIT_V(8); PG8_WAIT_L(0); PG8_BAR; PG8_MMA(1, 0, At, B0); PG8_MMA(1, 1, At, B1); PG8_BAR; PG8_SCHED;
        }
        if (wr == 0) PG8_BAR;
        const bool keep = E(acc, cur, wr, wc, fr, fq);
        if (!has_next) break;
        if (!keep) {
#pragma unroll
        for (int a = 0; a < 2; ++a)
#pragma unroll
            for (int b = 0; b < 2; ++b)
#pragma unroll
                for (int m = 0; m < 4; ++m)
#pragma unroll
                    for (int n = 0; n < 2; ++n) acc[a][b][m][n] = (f32x4){0.f, 0.f, 0.f, 0.f}; }
        cur = nxt; cA = nA; cB = nB; ++ui;
        if (wr == 1) PG8_BAR;
    }
    PG8_WAIT_V(0);
    PG8_BAR;
#undef PG8_SA
#undef PG8_SB
#undef PG8_STAGE
#undef PG8_LDA
#undef PG8_LDB
#undef PG8_MMA
#undef PG8_WAIT_V
#undef PG8_WAIT_L
#undef PG8_BAR
#undef PG8_SCHED
}
}
using pg8::Unit;
typedef f32x4 (&AccRef)[2][2][4][2];

#define XB_TMO      128
#define XB_XCNT(j)  (256  + 64 * (j))
#define XB_XSUB(j)  (1280 + 64 * (j))
#define XB_XGEN(j)  (2304 + 64 * (j))
#define XB_TOP      3328
#define XB_TOPGEN   3392
#define XCD_BAR_WORDS 3456
#define XB_SPIN_CAP (1u << 18)
__device__ __forceinline__ unsigned xb_ld(unsigned* p)              { return __hip_atomic_load(p, __ATOMIC_RELAXED, __HIP_MEMORY_SCOPE_AGENT); }
__device__ __forceinline__ unsigned xb_add(unsigned* p, unsigned v) { return __hip_atomic_fetch_add(p, v, __ATOMIC_RELAXED, __HIP_MEMORY_SCOPE_AGENT); }
__device__ __forceinline__ unsigned xb_xcc_id() { return (unsigned)__builtin_amdgcn_s_getreg((3 << 11) | 20) & 0xFu; }
#define XB_SPIN(cond, bar) do { unsigned _sp = 0; while (cond) { __builtin_amdgcn_s_sleep(1); \
    if ((++_sp & 255u) == 0u) { if (xb_ld(&(bar)[XB_TMO])) break; if (_sp > XB_SPIN_CAP) { atomicAdd(&(bar)[XB_TMO], 1u); break; } } } } while (0)
struct XcdBarrier { unsigned* bar; unsigned x; volatile LAS unsigned* st; };
__device__ __forceinline__ XcdBarrier xcd_barrier_post(unsigned* bar, volatile LAS unsigned* st) {
    XcdBarrier b; b.bar = bar; b.x = xb_xcc_id(); b.st = st;
    if (threadIdx.x == 0) (void)xb_add(&bar[XB_XCNT(b.x)], 1u);
    return b;
}
__device__ __forceinline__ void xcd_barrier_complete(unsigned* bar, unsigned x, unsigned& nloc, unsigned& nx) {
    const unsigned G = gridDim.x * gridDim.y * gridDim.z;
    unsigned sum, cnt, mine, sp = 0u;
    for (;;) {
        sum = 0u; cnt = 0u; mine = 0u;
#pragma unroll
        for (unsigned j = 0; j < 16; ++j) { const unsigned c = xb_ld(&bar[XB_XCNT(j)]); sum += c; cnt += (c > 0u) ? 1u : 0u; mine = (j == x) ? c : mine; }
        if (sum == G) break;
        __builtin_amdgcn_s_sleep(1);
        if ((++sp & 255u) == 0u) { if (xb_ld(&bar[XB_TMO])) break; if (sp > XB_SPIN_CAP) { atomicAdd(&bar[XB_TMO], 1u); break; } }
    }
    nloc = mine > 0u ? mine : 1u; nx = cnt > 0u ? cnt : 1u;
}
__device__ __forceinline__ void xcd_barrier(const XcdBarrier& b) {
    asm volatile("s_waitcnt vmcnt(0)" ::: "memory");
    __syncthreads();
    if (threadIdx.x == 0) {
        unsigned* bar = b.bar;
        __builtin_amdgcn_s_waitcnt(0);
        unsigned nloc = b.st[0], nx = b.st[1];
        if (nloc == 0u) { xcd_barrier_complete(bar, b.x, nloc, nx); b.st[0] = nloc; b.st[1] = nx; }
        const unsigned old = xb_add(&bar[XB_XSUB(b.x)], 1u);
        const unsigned gen = old / nloc;
        if (old + 1u == (gen + 1u) * nloc) {
            __builtin_amdgcn_fence(__ATOMIC_RELEASE, "agent");
            asm volatile("s_waitcnt vmcnt(0)" ::: "memory");
            const unsigned og = xb_add(&bar[XB_TOP], 1u);
            const unsigned tg = og / nx;
            if (og + 1u == (tg + 1u) * nx) xb_add(&bar[XB_TOPGEN], 1u);
            else XB_SPIN(xb_ld(&bar[XB_TOPGEN]) == tg, bar);
            __builtin_amdgcn_fence(__ATOMIC_ACQUIRE, "agent");
            xb_add(&bar[XB_XGEN(b.x)], 1u);
            asm volatile("s_waitcnt vmcnt(0)" ::: "memory");
        } else {
            XB_SPIN(xb_ld(&bar[XB_XGEN(b.x)]) == gen, bar);
            __builtin_amdgcn_fence(__ATOMIC_ACQUIRE, "agent");
            asm volatile("s_waitcnt vmcnt(0)" ::: "memory");
        }
    }
    __syncthreads();
}

struct Args { const float* in[20]; float* out; unsigned char* ws; int ph_lo, ph_hi; };
struct Frame {
    LAS unsigned char* lds;
    int tid, lane, wave, G, bid;
    const __attribute__((address_space(4))) Args* a;
    float* out; unsigned char* ws;
};
#define F_x (F.a->in[0])
#define F_c (F.a->in[1])
#define F_ctx (F.a->in[2])
#define F_cctx (F.a->in[3])
#define F_wmod (F.a->in[4])
#define F_bmod (F.a->in[5])
#define F_gpre (F.a->in[6])
#define F_gpost (F.a->in[7])
#define F_win (F.a->in[8])
#define F_rpb (F.a->in[9])
#define F_wfour (F.a->in[10])
#define F_cdw (F.a->in[11])
#define F_cdb (F.a->in[12])
#define F_lng (F.a->in[13])
#define F_lnb (F.a->in[14])
#define F_wpw (F.a->in[15])
#define F_pattn (F.a->in[16])
#define F_pfour (F.a->in[17])
#define F_pconv (F.a->in[18])
#define F_wout (F.a->in[19])
#define WSP(T, off) ((T*)(F.ws + (off)))

__device__ __forceinline__ int win_dstrow(int c) {
    if (c < 2048) return c;
    if (c < 2304) return -1;
    if (c < 2560) return c + 256;
    if (c < 2816) { const int j = c - 2560; return 2816 + (j >> 7) * 256 + (j & 127); }
    if (c < 3072) { const int j = c - 2816; return 2816 + (j >> 7) * 256 + 128 + (j & 127); }
    return c + 256;
}
__device__ __forceinline__ void transpose_item(const float* W, int ldw, int k0, int n0, bf16* dst, int ldk, int dstrow0, int dstk0, LAS float* scr, int lane) {
#pragma unroll
    for (int i = 0; i < 32; ++i) { const int kk = 2 * i + (lane >> 5); scr[kk * 33 + (lane & 31)] = W[(size_t)(k0 + kk) * ldw + n0 + (lane & 31)]; }
    LDS_WAIT(); asm volatile("" ::: "memory");
    const int c = lane & 7;
#pragma unroll
    for (int j = 0; j < 4; ++j) { const int n = (lane >> 3) + 8 * j; const LAS float* s = scr + (8 * c) * 33 + n;
        u32x4 o; o.x = cvt_pk_bf16(s[0], s[33]); o.y = cvt_pk_bf16(s[66], s[99]); o.z = cvt_pk_bf16(s[132], s[165]); o.w = cvt_pk_bf16(s[198], s[231]);
        *(u32x4*)(dst + (size_t)(dstrow0 + n) * ldk + dstk0 + k0 + 8 * c) = o; }
    LDS_WAIT(); asm volatile("" ::: "memory");
}
struct TDesc { const float* src; bf16* dst; int ldw, ldk; };
__device__ __forceinline__ void t_desc(Frame& F, int it, TDesc& d) {
    const int l = it / 4128; int r = it % 4128;
    if (r < 3072) { const int kb = r / 192, nb0 = r % 192, nb = nb0 < 64 ? nb0 : nb0 + 8; const int dr = win_dstrow(nb * 32);
        d.src = F_win + (size_t)l * D * INW + (size_t)(kb * 64) * INW + nb * 32; d.ldw = INW; d.dst = WSP(bf16, WS_BTIN) + (size_t)l * NIN * D + (size_t)dr * D + kb * 64; d.ldk = D; return; } r -= 3072;
    if (r < 256) { d.src = F_pattn + (size_t)l * 512 * D + (size_t)((r / 32) * 64) * D + (r % 32) * 32; d.ldw = D; d.dst = WSP(bf16, WS_BTCAT) + (size_t)l * D * D + (size_t)((r % 32) * 32) * D + (r / 32) * 64; d.ldk = D; return; } r -= 256;
    if (r < 128) { d.src = F_pfour + (size_t)l * 256 * D + (size_t)((r / 32) * 64) * D + (r % 32) * 32; d.ldw = D; d.dst = WSP(bf16, WS_BTCAT) + (size_t)l * D * D + (size_t)((r % 32) * 32) * D + 512 + (r / 32) * 64; d.ldk = D; return; } r -= 128;
    if (r < 128) { d.src = F_pconv + (size_t)l * 256 * D + (size_t)((r / 32) * 64) * D + (r % 32) * 32; d.ldw = D; d.dst = WSP(bf16, WS_BTCAT) + (size_t)l * D * D + (size_t)((r % 32) * 32) * D + 768 + (r / 32) * 64; d.ldk = D; return; } r -= 128;
    if (r < 512) { d.src = F_wout + (size_t)l * D * D + (size_t)((r / 32) * 64) * D + (r % 32) * 32; d.ldw = D; d.dst = WSP(bf16, WS_BTOUT) + (size_t)l * D * D + (size_t)((r % 32) * 32) * D + (r / 32) * 64; d.ldk = D; return; } r -= 512;
    d.src = F_wpw + (size_t)l * 65536 + (size_t)((r / 8) * 64) * 256 + (r % 8) * 32; d.ldw = 256; d.dst = WSP(bf16, WS_BTPW) + (size_t)l * 65536 + (size_t)((r % 8) * 32) * 256 + (r / 8) * 64; d.ldk = 256;
}
__device__ __forceinline__ void t_load(const TDesc& d, int lane, float (&v)[32]) {
#pragma unroll
    for (int i = 0; i < 32; ++i) v[i] = d.src[(size_t)(2 * i + (lane >> 5)) * d.ldw + (lane & 31)];
}
__device__ __forceinline__ void t_store(const TDesc& d, int lane, const float (&v)[32], LAS float* scr) {
#pragma unroll
    for (int i = 0; i < 32; ++i) scr[(2 * i + (lane >> 5)) * 33 + (lane & 31)] = v[i];
    LDS_WAIT(); asm volatile("" ::: "memory");
    const int c = lane & 7;
#pragma unroll
    for (int j = 0; j < 4; ++j) { const int n = (lane >> 3) + 8 * j; const LAS float* sp = scr + (8 * c) * 33 + n;
        u32x4 o; o.x = cvt_pk_bf16(sp[0], sp[33]); o.y = cvt_pk_bf16(sp[66], sp[99]); o.z = cvt_pk_bf16(sp[132], sp[165]); o.w = cvt_pk_bf16(sp[198], sp[231]);
        *(u32x4*)(d.dst + (size_t)n * d.ldk + 8 * c) = o; }
    LDS_WAIT(); asm volatile("" ::: "memory");
}
__device__ __forceinline__ void p0_prologue(Frame& F) {
    LAS float* scr = (LAS float*)(F.lds + F.wave * 16384);
    const int gw = F.bid * 8 + F.wave, NGW = F.G * 8, lane = F.lane;
    if (F.bid < 96) {
        LAS float* sc = (LAS float*)F.lds;
        LAS float* red = sc + 5 * 1024;
        for (int i = F.tid; i < 5 * 1024; i += 512) { const int r = i >> 10, k = i & 1023; sc[i] = fast_silu(r < 4 ? F_c[r * D + k] : F_cctx[k]); }
        __syncthreads();
        const int l = F.bid / 48, n = (F.bid % 48) * 64 + lane;
        const float* w = F_wmod + (size_t)l * D * 3072 + (size_t)(128 * F.wave) * 3072 + n;
        const LAS float* scw = sc + 128 * F.wave;
        float a0 = 0.f, a1 = 0.f, a2 = 0.f, a3 = 0.f, a4 = 0.f;
#pragma unroll 16
        for (int k = 0; k < 128; ++k) { const float wv = w[(size_t)k * 3072];
            a0 += scw[k] * wv; a1 += scw[1024 + k] * wv; a2 += scw[2048 + k] * wv; a3 += scw[3072 + k] * wv; a4 += scw[4096 + k] * wv; }
        LAS float* rw = red + (F.wave * 5) * 64 + lane;
        rw[0] = a0; rw[64] = a1; rw[128] = a2; rw[192] = a3; rw[256] = a4;
        __syncthreads();
        if (F.tid < 320) { const int q = F.tid >> 6;
            float v = 0.f;
#pragma unroll
            for (int ww = 0; ww < 8; ++ww) v += red[(ww * 5 + q) * 64 + lane];
            v += F_bmod[l * 3072 + n];
            if (n >= 2048) v = v * F_gpost[l * D + n - 2048];
            else if (n >= 1024) v = F_gpre[l * D + n - 1024] * (1.f + v);
            WSP(float, WS_MODV)[((size_t)l * 5 + q) * 3072 + n] = v; }
        __syncthreads();
    }
    LAS float* trig = (LAS float*)(F.lds + 8 * 16384);
    if (F.tid < 64) { float sn, cs; sincospif((float)F.tid * (1.f / 32.f), &sn, &cs); trig[F.tid] = cs; trig[64 + F.tid] = sn; }
    __syncthreads();
    for (int it = NGW - 1 - gw; it < 512; it += NGW) {
        const int l = it >> 8, row = it & 255, g = row >> 6, d = row & 63;
        const float* wf = F_wfour + (size_t)l * 65536 + (size_t)(g * 64) * 256 + lane;
        float ac[4] = {0.f, 0.f, 0.f, 0.f}, as[4] = {0.f, 0.f, 0.f, 0.f};
#pragma unroll 8
        for (int dp = 0; dp < 64; ++dp) { const int ix = (d * dp) & 63; const float cs = trig[ix], sn = trig[64 + ix];
#pragma unroll
            for (int q = 0; q < 4; ++q) { const float wv = wf[dp * 256 + 64 * q]; ac[q] += cs * wv; as[q] += sn * wv; } }
        float* wc = WSP(float, WS_WCS) + ((size_t)(l * 2 + 0) * 256 + row) * 256;
        float* wsn = WSP(float, WS_WCS) + ((size_t)(l * 2 + 1) * 256 + row) * 256;
#pragma unroll
        for (int q = 0; q < 4; ++q) { wc[lane + 64 * q] = ac[q] * 0.125f; wsn[lane + 64 * q] = as[q] * 0.125f; }
    }
    {
        constexpr int NT = 2 * 4128;
        TDesc cur, nxt; float va[32], vb[32];
        int it = gw;
        if (it < NT) { t_desc(F, it, cur); t_load(cur, lane, va); }
        while (it < NT) {
            const int itn = it + NGW;
            if (itn < NT) { t_desc(F, itn, nxt); t_load(nxt, lane, vb); }
            t_store(cur, lane, va, scr);
            cur = nxt; it = itn;
#pragma unroll
            for (int i = 0; i < 32; ++i) va[i] = vb[i];
        }
    }
    const int gt = F.bid * 512 + F.tid, NGT = F.G * 512;
    for (int i = gt; i < 128 * 128; i += NGT) {
        const int n = i >> 7, k = i & 127, rip = n >> 6, k1 = n & 63, ri = k >> 6, n1 = k & 63;
        float sn, cs; sincospif((float)((k1 * n1) & 63) * (1.f / 32.f), &sn, &cs);
        const float v = rip == 0 ? (ri == 0 ? cs : -sn) : (ri == 0 ? -sn : -cs);
        WSP(bf16, WS_D1T)[i] = (bf16)f2bf(v);
    }
    for (int i = gt; i < 64 * 128; i += NGT) {
        const int k2 = i >> 7, k = i & 127, ri = k >> 6, n2 = k & 63;
        float sn, cs; sincospif((float)((k2 * n2) & 63) * (1.f / 32.f), &sn, &cs);
        WSP(bf16, WS_E2T)[i] = (bf16)f2bf((ri == 0 ? cs : sn) * (1.f / 64.f));
    }
    for (int i = gt; i < 64 * 64; i += NGT) {
        const int k1 = i >> 6, n2 = i & 63;
        float sn, cs; sincospif((float)(k1 * n2) * (1.f / 2048.f), &sn, &cs);
        WSP(float, WS_TW)[2 * i] = cs; WSP(float, WS_TW)[2 * i + 1] = sn;
    }
    for (int i = gt; i < 256 * 512; i += NGT) {
        const int k = i >> 9, kk = i & 511, ri = kk >> 8, n = kk & 255;
        float sn, cs; sincospif((float)((k * n) & 255) * (1.f / 128.f), &sn, &cs);
        WSP(bf16, WS_DCTX)[i] = (bf16)f2bf((ri == 0 ? cs : -sn) * (1.f / 16.f));
    }
}

struct Row16 { float v[16]; };
__device__ __forceinline__ void ld_row_f32(const float* p, int lane, Row16& r) {
#pragma unroll
    for (int j = 0; j < 2; ++j) { const f32x4 a = *(const f32x4*)(p + 512 * j + 8 * lane), b = *(const f32x4*)(p + 512 * j + 8 * lane + 4);
        r.v[8 * j + 0] = a.x; r.v[8 * j + 1] = a.y; r.v[8 * j + 2] = a.z; r.v[8 * j + 3] = a.w; r.v[8 * j + 4] = b.x; r.v[8 * j + 5] = b.y; r.v[8 * j + 6] = b.z; r.v[8 * j + 7] = b.w; }
}
__device__ __forceinline__ void st_row_f32(float* p, int lane, const Row16& r) {
#pragma unroll
    for (int j = 0; j < 2; ++j) { *(f32x4*)(p + 512 * j + 8 * lane) = (f32x4){r.v[8 * j], r.v[8 * j + 1], r.v[8 * j + 2], r.v[8 * j + 3]};
        *(f32x4*)(p + 512 * j + 8 * lane + 4) = (f32x4){r.v[8 * j + 4], r.v[8 * j + 5], r.v[8 * j + 6], r.v[8 * j + 7]}; }
}
__device__ __forceinline__ void ld_row_bf16(const bf16* p, int lane, Row16& r) {
#pragma unroll
    for (int j = 0; j < 2; ++j) { const u32x4 a = *(const u32x4*)(p + 512 * j + 8 * lane);
        r.v[8 * j + 0] = bflo(a.x); r.v[8 * j + 1] = bfhi(a.x); r.v[8 * j + 2] = bflo(a.y); r.v[8 * j + 3] = bfhi(a.y); r.v[8 * j + 4] = bflo(a.z); r.v[8 * j + 5] = bfhi(a.z); r.v[8 * j + 6] = bflo(a.w); r.v[8 * j + 7] = bfhi(a.w); }
}
__device__ __forceinline__ void st_row_bf16(bf16* p, int lane, const Row16& r) {
#pragma unroll
    for (int j = 0; j < 2; ++j) { u32x4 o; o.x = cvt_pk_bf16(r.v[8 * j], r.v[8 * j + 1]); o.y = cvt_pk_bf16(r.v[8 * j + 2], r.v[8 * j + 3]); o.z = cvt_pk_bf16(r.v[8 * j + 4], r.v[8 * j + 5]); o.w = cvt_pk_bf16(r.v[8 * j + 6], r.v[8 * j + 7]);
        *(u32x4*)(p + 512 * j + 8 * lane) = o; }
}
struct RowVecs { Row16 g2, g1, sh; };
__device__ __forceinline__ void row_apply(Frame& F, int mode, int row, bool lat, Row16& xv, const Row16& yv, float sp, const RowVecs& V) {
    const int lane = F.lane;
    if (mode != 0) {
        const float rs = __builtin_amdgcn_rsqf(wave_sum(sp) * (1.f / D) + EPS);
#pragma unroll
        for (int i = 0; i < 16; ++i) xv.v[i] += V.g2.v[i] * yv.v[i] * rs;
        st_row_f32(F.out + (size_t)row * D, lane, xv);
    }
    if (mode != 2) {
        float s2 = 0.f;
#pragma unroll
        for (int i = 0; i < 16; ++i) s2 += xv.v[i] * xv.v[i];
        const float rs = __builtin_amdgcn_rsqf(wave_sum(s2) * (1.f / D) + EPS);
#pragma unroll
        for (int i = 0; i < 16; ++i) xv.v[i] = xv.v[i] * rs * V.g1.v[i] + V.sh.v[i];
        st_row_bf16(WSP(bf16, WS_XN) + (size_t)row * D, lane, xv);
    }
    (void)lat;
}
__device__ __forceinline__ void row_run(Frame& F, int mode, int b, int first, int stride, int nper) {
    const int lane = F.lane;
    const bf16* Y = WSP(bf16, WS_Y); const float* SSQ = WSP(float, WS_SSQ);
    const float* xsrc = mode == 2 ? F.out : F_x;
    RowVecs V;
#pragma unroll
    for (int i = 0; i < 16; ++i) { V.g2.v[i] = 0.f; V.g1.v[i] = 0.f; V.sh.v[i] = 0.f; }
    if (mode != 0) ld_row_f32(WSP(float, WS_MODV) + ((size_t)(mode - 1) * 5 + b) * 3072 + 2048, lane, V.g2);
    if (mode != 2) { ld_row_f32(WSP(float, WS_MODV) + ((size_t)mode * 5 + b) * 3072 + 1024, lane, V.g1); ld_row_f32(WSP(float, WS_MODV) + ((size_t)mode * 5 + b) * 3072, lane, V.sh); }
    Row16 xv, yv; float sp = 0.f;
#pragma unroll
    for (int i = 0; i < 16; ++i) yv.v[i] = 0.f;
    int row = first;
    ld_row_f32(xsrc + (size_t)row * D, lane, xv);
    if (mode != 0) { ld_row_bf16(Y + (size_t)row * D, lane, yv); sp = lane < 16 ? SSQ[(size_t)row * 16 + lane] : 0.f; }
    for (int i = 0; i < nper; ++i) {
        const int nrow = row + stride; Row16 nx, ny; float nsp = 0.f;
#pragma unroll
        for (int e = 0; e < 16; ++e) { nx.v[e] = 0.f; ny.v[e] = 0.f; }
        if (i + 1 < nper) { ld_row_f32(xsrc + (size_t)nrow * D, lane, nx); if (mode != 0) { ld_row_bf16(Y + (size_t)nrow * D, lane, ny); nsp = lane < 16 ? SSQ[(size_t)nrow * 16 + lane] : 0.f; } }
        row_apply(F, mode, row, true, xv, yv, sp, V);
        xv = nx; yv = ny; sp = nsp; row = nrow;
    }
}
__device__ __forceinline__ void row_phase(Frame& F, int mode) {
    const int gw = F.bid * 8 + F.wave, NGW = F.G * 8, lane = F.lane;
    const int QW = NGW / 4, b = gw / QW, li = gw % QW, nper = SEQ / QW;
    row_run(F, mode, b, b * SEQ + li, QW, nper);
    if (mode == 0 && gw < MC) {
        RowVecs V; Row16 xv, yv;
#pragma unroll
        for (int i = 0; i < 16; ++i) { V.g2.v[i] = 0.f; yv.v[i] = 0.f; }
        ld_row_f32(WSP(float, WS_MODV) + ((size_t)0 * 5 + 4) * 3072 + 1024, lane, V.g1); ld_row_f32(WSP(float, WS_MODV) + ((size_t)0 * 5 + 4) * 3072, lane, V.sh);
        ld_row_f32(F_ctx + (size_t)gw * D, lane, xv);
        row_apply(F, 0, ML + gw, false, xv, yv, 0.f, V);
    }
}
__device__ __forceinline__ void fold_phase(Frame& F) {
    LAS float* sW = (LAS float*)F.lds;
    LAS float* sA = (LAS float*)(F.lds + 65536) + F.wave * 2048;
    const int lane = F.lane, tid = F.tid;
    for (int id = F.bid; id < 256; id += F.G) {
        const int l = id >> 7, cs = (id >> 6) & 1, jq = (id >> 4) & 3, kg = id & 15, kb = kg * 8 + F.wave;
        const float* wcs = WSP(float, WS_WCS) + (size_t)(l * 2 + cs) * 65536 + 64 * jq;
        const float* wi = F_win + (size_t)l * D * INW + (size_t)(kb * 8) * INW + OUF;
        f32x4 pw[8], pa[8];
#pragma unroll
        for (int i = 0; i < 8; ++i) { const int idx = tid + 512 * i; pw[i] = *(const f32x4*)(wcs + (size_t)(idx >> 4) * 256 + 4 * (idx & 15)); }
#pragma unroll
        for (int i = 0; i < 8; ++i) pa[i] = *(const f32x4*)(wi + (size_t)i * INW + 4 * lane);
#pragma unroll
        for (int i = 0; i < 8; ++i) { const int idx = tid + 512 * i; *(LAS f32x4*)(sW + (idx >> 4) * 64 + 4 * (idx & 15)) = pw[i]; }
#pragma unroll
        for (int i = 0; i < 8; ++i) *(LAS f32x4*)(sA + i * 256 + 4 * lane) = pa[i];
        __syncthreads();
        float a[8] = {0.f, 0.f, 0.f, 0.f, 0.f, 0.f, 0.f, 0.f};
#pragma unroll 8
        for (int m = 0; m < 256; ++m) { const float w = sW[m * 64 + lane];
#pragma unroll
            for (int i = 0; i < 8; ++i) a[i] += sA[i * 256 + m] * w; }
        u32x4 o; o.x = cvt_pk_bf16(a[0], a[1]); o.y = cvt_pk_bf16(a[2], a[3]); o.z = cvt_pk_bf16(a[4], a[5]); o.w = cvt_pk_bf16(a[6], a[7]);
        *(u32x4*)(WSP(bf16, WS_BTIN) + (size_t)l * NIN * D + (size_t)(2048 + cs * 256 + 64 * jq + lane) * D + kb * 8) = o;
        __syncthreads();
    }
}

struct SchedA {
    int G, c, layer;
    __device__ __forceinline__ bool next(int i, Unit& u) const {
        const int L = i * G + c; const int nlat = 64 * 26, ntot = nlat + (layer == 0 ? 104 : 0);
        if (L >= ntot) return false;
        if (L < nlat) pg8::tile_of(L, 64, 26, u.pm, u.pn);
        else { const int j = L - nlat; u.pm = 64 + j / 26; u.pn = j % 26; }
        u.k0 = 0; u.nt = 16; u.tag = 0; return true;
    }
};
struct SchedTile {
    int pm, pn, chain;
    __device__ __forceinline__ bool next(int i, Unit& u) const {
        if (i >= (chain ? 3 : 1)) return false;
        u.pm = pm; u.pn = pn;
        if (chain) { u.k0 = i == 0 ? 0 : (i == 1 ? 512 : 768); u.nt = i == 0 ? 8 : 4; u.tag = i; } else { u.k0 = 0; u.nt = 16; u.tag = 0; }
        return true;
    }
};
struct SchedC1 {
    int G, c, ntiles;
    __device__ __forceinline__ bool next(int i, Unit& u) const {
        const int T = (i / 3) * G + c, seg = i % 3;
        if (T >= ntiles) return false;
        if (T < 256) pg8::tile_of(T, 64, 4, u.pm, u.pn); else { u.pm = 64 + ((T - 256) >> 2); u.pn = (T - 256) & 3; }
        u.k0 = seg == 0 ? 0 : (seg == 1 ? 512 : 768); u.nt = seg == 0 ? 8 : 4; u.tag = seg; return true;
    }
};
struct SchedC2 {
    int G, c, ntiles;
    __device__ __forceinline__ bool next(int i, Unit& u) const {
        const int T = i * G + c;
        if (T >= ntiles) return false;
        if (T < 256) pg8::tile_of(T, 64, 4, u.pm, u.pn); else { u.pm = 64 + ((T - 256) >> 2); u.pn = (T - 256) & 3; }
        u.k0 = 0; u.nt = 16; u.tag = 0; return true;
    }
};
struct SchedFc {
    int b;
    __device__ __forceinline__ bool next(int i, Unit& u) const { if (i > 0) return false; u.pm = 0; u.pn = b; u.k0 = 0; u.nt = 8; u.tag = 0; return true; }
};

struct EpiIn {
    bf16 *Q, *K, *VTL, *VTC, *GA, *UFL, *ZT, *GF, *GLU, *GC; unsigned char* S;
    __device__ __forceinline__ bool operator()(AccRef acc, const Unit& u, int wr, int wc, int fr, int fq) const {
        const int pn = u.pn, pm = u.pm;
        const int rl = wr * 64 + fr;
        const size_t row0 = (size_t)pm * 256 + rl;
        const int cl = wc * 32 + 8 * fq;
        if (pn < 4 || (pn >= 6 && pn < 8) || pn == 10 || pn == 13) {
            bf16* base; int ldc, col0; int act;
            if (pn < 2) { base = Q; ldc = 512; col0 = pn * 256; act = 1; }
            else if (pn < 4) { base = K; ldc = 512; col0 = (pn - 2) * 256; act = 0; }
            else if (pn < 8) { base = GA; ldc = 512; col0 = (pn - 6) * 256; act = 2; }
            else if (pn == 10) { base = GF; ldc = 256; col0 = 0; act = 2; }
            else { base = GC; ldc = 256; col0 = 0; act = 2; }
#pragma unroll
            for (int ai = 0; ai < 2; ++ai)
#pragma unroll
                for (int m = 0; m < 4; ++m) { bf16* rp = base + (row0 + ai * 128 + m * 16) * ldc + col0 + cl;
#pragma unroll
                    for (int bj = 0; bj < 2; ++bj) { f32x4 v0 = acc[ai][bj][m][0], v1 = acc[ai][bj][m][1];
                        if (act == 1) { v0 = v0 * QSCALE; v1 = v1 * QSCALE; }
                        if (act == 2) {
#pragma unroll
                            for (int e = 0; e < 4; ++e) { v0[e] = fast_silu(v0[e]); v1[e] = fast_silu(v1[e]); } }
                        u32x4 w; w.x = cvt_pk_bf16(v0[0], v0[1]); w.y = cvt_pk_bf16(v0[2], v0[3]); w.z = cvt_pk_bf16(v1[0], v1[1]); w.w = cvt_pk_bf16(v1[2], v1[3]);
                        *(u32x4*)(rp + bj * 128) = w; } }
        } else if (pn < 6) {
#pragma unroll
            for (int ai = 0; ai < 2; ++ai)
#pragma unroll
                for (int m = 0; m < 4; ++m) { const int t = ai * 128 + m * 16 + rl;
                    bf16* tb; size_t ts;
                    if (pm < 64) { tb = VTL + (size_t)(pm >> 4) * 8 * 64 * 4096 + (pm & 15) * 256 + t; ts = 4096; } else { tb = VTC + (size_t)(pm - 64) * 8 * 64 * 256 + t; ts = 256; }
#pragma unroll
                    for (int bj = 0; bj < 2; ++bj)
#pragma unroll
                        for (int n = 0; n < 2; ++n)
#pragma unroll
                            for (int e = 0; e < 4; ++e) { const int vcol = (pn - 4) * 256 + bj * 128 + cl + 4 * n + e;
                                tb[(size_t)vcol * ts] = (bf16)f2bf(acc[ai][bj][m][n][e]); } }
        } else if (pn < 10) {
            const int ri = pn - 8;
#pragma unroll
            for (int ai = 0; ai < 2; ++ai)
#pragma unroll
                for (int m = 0; m < 4; ++m) { const int t = ai * 128 + m * 16 + rl;
                    if (pm < 64) { const int b = pm >> 4, ntok = (pm & 15) * 256 + t;
#pragma unroll
                        for (int bj = 0; bj < 2; ++bj)
#pragma unroll
                            for (int n = 0; n < 2; ++n) { const int cb4 = (bj * 128 + cl) / 4 + n; const f32x4 v = acc[ai][bj][m][n];
                                u32x2 w; w.x = cvt_pk_bf16(v[0], v[1]); w.y = cvt_pk_bf16(v[2], v[3]);
                                *(u32x2*)(UFL + ((size_t)((b * 2 + ri) * 64 + cb4) * 4096 + ntok) * 4) = w; }
                    } else { const int b = pm - 64;
#pragma unroll
                        for (int bj = 0; bj < 2; ++bj)
#pragma unroll
                            for (int n = 0; n < 2; ++n)
#pragma unroll
                                for (int e = 0; e < 4; ++e) { const int ch = bj * 128 + cl + 4 * n + e;
                                    ZT[((size_t)(b * 256 + ch) * 2 + ri) * 256 + t] = (bf16)f2bf(acc[ai][bj][m][n][e]); } } }
        } else if (pn < 13) {
            const int col0 = (pn - 11) * 128 + cl;
#pragma unroll
            for (int ai = 0; ai < 2; ++ai)
#pragma unroll
                for (int m = 0; m < 4; ++m) { f32x4 a0 = acc[ai][0][m][0], a1 = acc[ai][0][m][1]; const f32x4 b0 = acc[ai][1][m][0], b1 = acc[ai][1][m][1];
#pragma unroll
                    for (int e = 0; e < 4; ++e) { a0[e] *= fast_sigmoid(b0[e]); a1[e] *= fast_sigmoid(b1[e]); }
                    u32x4 w; w.x = cvt_pk_bf16(a0[0], a0[1]); w.y = cvt_pk_bf16(a0[2], a0[3]); w.z = cvt_pk_bf16(a1[0], a1[1]); w.w = cvt_pk_bf16(a1[2], a1[3]);
                    *(u32x4*)(GLU + (row0 + ai * 128 + m * 16) * 256 + col0) = w; }
        } else {
            const int g = (pn - 14) >> 2, pl = (pn - 14) & 3;
            unsigned char* sb = S + (size_t)g * MT * 1024 + pl * 256 + 64 * wc + 16 * fq;
#pragma unroll
            for (int ai = 0; ai < 2; ++ai)
#pragma unroll
                for (int m = 0; m < 4; ++m) { unsigned w[4];
#pragma unroll
                    for (int bj = 0; bj < 2; ++bj)
#pragma unroll
                        for (int n = 0; n < 2; ++n) { const f32x4 v = acc[ai][bj][m][n]; unsigned p = 0;
#pragma unroll
                            for (int e = 0; e < 4; ++e) { const unsigned q = (unsigned)(fast_sigmoid(v[e]) * 255.f + 0.5f); p |= q << (8 * e); }
                            w[bj * 2 + n] = p; }
                    *(u32x4*)(sb + (row0 + ai * 128 + m * 16) * 1024) = (u32x4){w[0], w[1], w[2], w[3]}; }
        }
        return false;
    }
};
struct EpiC1 {
    bf16* MG; const unsigned char* S;
    __device__ __forceinline__ bool operator()(AccRef acc, const Unit& u, int wr, int wc, int fr, int fq) const {
        const int seg = u.tag; const size_t row0 = (size_t)u.pm * 256 + wr * 64 + fr;
        const unsigned char* sb = S + (size_t)seg * MT * 1024 + u.pn * 256 + 64 * wc + 16 * fq;
        const unsigned char* sn = sb + (size_t)MT * 1024;
        bf16* mb = MG + u.pn * 256 + wc * 32 + 8 * fq;
#pragma unroll
        for (int ai = 0; ai < 2; ++ai)
#pragma unroll
            for (int m = 0; m < 4; ++m) { const size_t row = row0 + ai * 128 + m * 16;
                const u32x4 sv = *(const u32x4*)(sb + row * 1024);
                u32x4 nv = (u32x4){0u, 0u, 0u, 0u}; if (seg < 2) nv = *(const u32x4*)(sn + row * 1024);
#pragma unroll
                for (int bj = 0; bj < 2; ++bj) {
                    const unsigned g0 = bj == 0 ? sv.x : sv.z, g1 = bj == 0 ? sv.y : sv.w, h0 = bj == 0 ? nv.x : nv.z, h1 = bj == 0 ? nv.y : nv.w;
#pragma unroll
                    for (int e = 0; e < 4; ++e) {
                        float f0 = (float)max((g0 >> (8 * e)) & 255u, 1u), f1 = (float)max((g1 >> (8 * e)) & 255u, 1u);
                        if (seg < 2) { f0 *= __builtin_amdgcn_rcpf((float)max((h0 >> (8 * e)) & 255u, 1u)); f1 *= __builtin_amdgcn_rcpf((float)max((h1 >> (8 * e)) & 255u, 1u)); }
                        else { f0 *= (1.f / 255.f); f1 *= (1.f / 255.f); }
                        acc[ai][bj][m][0][e] *= f0; acc[ai][bj][m][1][e] *= f1; }
                    if (seg == 2) { const f32x4 v0 = acc[ai][bj][m][0], v1 = acc[ai][bj][m][1];
                        u32x4 w; w.x = cvt_pk_bf16(v0[0], v0[1]); w.y = cvt_pk_bf16(v0[2], v0[3]); w.z = cvt_pk_bf16(v1[0], v1[1]); w.w = cvt_pk_bf16(v1[2], v1[3]);
                        *(u32x4*)(mb + row * 1024 + bj * 128) = w; } } }
        return seg < 2;
    }
};
struct EpiC2 {
    bf16* Y; float* SSQ;
    __device__ __forceinline__ bool operator()(AccRef acc, const Unit& u, int wr, int wc, int fr, int fq) const {
        const size_t row0 = (size_t)u.pm * 256 + wr * 64 + fr;
        bf16* yb = Y + u.pn * 256 + wc * 32 + 8 * fq;
#pragma unroll
        for (int ai = 0; ai < 2; ++ai)
#pragma unroll
            for (int m = 0; m < 4; ++m) { const size_t row = row0 + ai * 128 + m * 16; float s = 0.f;
#pragma unroll
                for (int bj = 0; bj < 2; ++bj) { const f32x4 v0 = acc[ai][bj][m][0], v1 = acc[ai][bj][m][1];
                    s += (v0[0] * v0[0] + v0[1] * v0[1]) + (v0[2] * v0[2] + v0[3] * v0[3]) + (v1[0] * v1[0] + v1[1] * v1[1]) + (v1[2] * v1[2] + v1[3] * v1[3]);
                    u32x4 w; w.x = cvt_pk_bf16(v0[0], v0[1]); w.y = cvt_pk_bf16(v0[2], v0[3]); w.z = cvt_pk_bf16(v1[0], v1[1]); w.w = cvt_pk_bf16(v1[2], v1[3]);
                    *(u32x4*)(yb + row * 1024 + bj * 128) = w; }
                s += __shfl_xor(s, 16); s += __shfl_xor(s, 32);
                if (fq == 0) SSQ[row * 16 + u.pn * 4 + wc] = s; }
        return false;
    }
};
struct EpiFc {
    bf16* ACAT; const bf16* GF;
    __device__ __forceinline__ bool operator()(AccRef acc, const Unit& u, int wr, int wc, int fr, int fq) const {
        const size_t row0 = (size_t)ML + u.pn * 256 + wr * 64 + fr; const int cl = wc * 32 + 8 * fq;
#pragma unroll
        for (int ai = 0; ai < 2; ++ai)
#pragma unroll
            for (int m = 0; m < 4; ++m) { const size_t row = row0 + ai * 128 + m * 16;
#pragma unroll
                for (int bj = 0; bj < 2; ++bj) { f32x4 v0 = acc[ai][bj][m][0], v1 = acc[ai][bj][m][1];
                    const u32x4 gq = *(const u32x4*)(GF + row * 256 + bj * 128 + cl);
                    v0[0] *= bflo(gq.x); v0[1] *= bfhi(gq.x); v0[2] *= bflo(gq.y); v0[3] *= bfhi(gq.y); v1[0] *= bflo(gq.z); v1[1] *= bfhi(gq.z); v1[2] *= bflo(gq.w); v1[3] *= bfhi(gq.w);
                    u32x4 w; w.x = cvt_pk_bf16(v0[0], v0[1]); w.y = cvt_pk_bf16(v0[2], v0[3]); w.z = cvt_pk_bf16(v1[0], v1[1]); w.w = cvt_pk_bf16(v1[2], v1[3]);
                    *(u32x4*)(ACAT + row * 1024 + 512 + bj * 128 + cl) = w; } }
        return false;
    }
};

constexpr int AT_KS = 72, AT_VS = 68;
constexpr int AT_KOFF = 0, AT_VOFF = 4 * 64 * AT_KS * 2, AT_BOFF = AT_VOFF + 4 * 64 * AT_VS * 2;
__device__ __forceinline__ void attn_unit(Frame& F, int unit, int layer) {
    const int tid = F.tid, lane = F.lane, w = F.wave, l31 = lane & 31, hh = lane >> 5;
    const bf16* Qp = WSP(bf16, WS_Q); const bf16* Kp = WSP(bf16, WS_K); const bf16* GA = WSP(bf16, WS_GA); bf16* ACAT = WSP(bf16, WS_XN);
    const bool isctx = unit >= 512;
    int b, h, R0 = 0, nwin = 0, r = 0, c0 = 0; size_t qtok;
    if (!isctx) { b = unit >> 7; h = (unit >> 4) & 7; const int rb = unit & 15; const int ra = 4 * rb;
        R0 = min(max(ra - 4, 0), 56); const int R1 = min(max(ra + 3 - 4, 0), 56) + 8; nwin = R1 - R0;
        r = ra + (w >> 1); c0 = 32 * (w & 1); qtok = (size_t)b * SEQ + r * 64 + c0 + l31; }
    else { const int j = unit - 512; b = j >> 3; h = j & 7; qtok = (size_t)ML + b * CTX + 32 * w + l31; }
    const int myrs = isctx ? 0 : (min(max(r - 4, 0), 56) - R0);
    const int nt = nwin + 4;
    LAS float* btab = (LAS float*)(F.lds + AT_BOFF);
    if (!isctx) for (int i = tid; i < 465; i += 512) btab[64 + i] = F_rpb[((size_t)layer * NH + h) * 465 + i] * LOG2E;
    bf16x8 qf[4];
#pragma unroll
    for (int s = 0; s < 4; ++s) qf[s] = *(const bf16x8*)(Qp + qtok * 512 + h * 64 + 16 * s + 8 * hh);
    const int srow = tid >> 3, sch = tid & 7;
    const bf16* vtl = WSP(bf16, WS_VTL) + ((size_t)(b * 8 + h) * 64 + srow) * 4096 + sch * 8;
    const bf16* vtc = WSP(bf16, WS_VTC) + ((size_t)(b * 8 + h) * 64 + srow) * 256 + sch * 8;
    u32x4 kA, vA, kB, vB;
#define AT_LOAD(t, kreg, vreg) do { const int _t = (t); size_t ktok; const bf16* vp; \
        if (_t < nwin) { ktok = (size_t)b * SEQ + (size_t)(R0 + _t) * 64; vp = vtl + (R0 + _t) * 64; } else { ktok = (size_t)ML + b * CTX + (_t - nwin) * 64; vp = vtc + (_t - nwin) * 64; } \
        kreg = *(const u32x4*)(Kp + (ktok + srow) * 512 + h * 64 + sch * 8); vreg = *(const u32x4*)vp; } while (0)
#define AT_WRITE(buf, kreg, vreg) do { *(LAS u32x4*)(F.lds + AT_KOFF + (buf) * 64 * AT_KS * 2 + (srow * AT_KS + sch * 8) * 2) = kreg; \
        LAS u32x2* _v = (LAS u32x2*)(F.lds + AT_VOFF + (buf) * 64 * AT_VS * 2 + (srow * AT_VS + sch * 8) * 2); _v[0] = (u32x2){vreg.x, vreg.y}; _v[1] = (u32x2){vreg.z, vreg.w}; } while (0)
    AT_LOAD(0, kA, vA); AT_LOAD(1, kB, vB); AT_WRITE(0, kA, vA); AT_WRITE(1, kB, vB);
    __syncthreads();
    f32x16 O0, O1;
#pragma unroll
    for (int i = 0; i < 16; ++i) { O0[i] = 0.f; O1[i] = 0.f; }
    float mrun = -1e30f, lrun = 0.f;
    const int qc = c0 + l31; const int cs = min(max(qc - 8, 0), 48);
#define AT_COMPUTE(tt, bufi) do { const int t = (tt); const bool win = t < nwin; \
        if (!win || (t >= myrs && t < myrs + 8)) { \
            const LAS unsigned char* kb = F.lds + AT_KOFF + (bufi) * 64 * AT_KS * 2; \
            const LAS unsigned char* vb = F.lds + AT_VOFF + (bufi) * 64 * AT_VS * 2; \
            f32x16 s0, s1; \
            _Pragma("unroll") for (int i = 0; i < 16; ++i) { s0[i] = 0.f; s1[i] = 0.f; } \
            _Pragma("unroll") for (int s = 0; s < 4; ++s) { \
                const bf16x8 k0 = *(const LAS bf16x8*)(kb + ((l31) * AT_KS + 16 * s + 8 * hh) * 2); \
                const bf16x8 k1 = *(const LAS bf16x8*)(kb + ((32 + l31) * AT_KS + 16 * s + 8 * hh) * 2); \
                s0 = __builtin_amdgcn_mfma_f32_32x32x16_bf16(k0, qf[s], s0, 0, 0, 0); \
                s1 = __builtin_amdgcn_mfma_f32_32x32x16_bf16(k1, qf[s], s1, 0, 0, 0); } \
            if (win) { const int dr = (R0 + t) - r + 7; const LAS float* bp = btab + 64 + dr * 31 + 15 - qc + 4 * hh; const int lo = 4 * hh - cs; \
                float bv0[16], bv1[16];         \
                _Pragma("unroll") for (int i = 0; i < 16; ++i) { const int kc = (i & 3) + 8 * (i >> 2); bv0[i] = bp[kc]; bv1[i] = bp[kc + 32]; } \
                _Pragma("unroll") for (int i = 0; i < 16; ++i) { const int kc = (i & 3) + 8 * (i >> 2); \
                    const float a0 = s0[i] + bv0[i], a1 = s1[i] + bv1[i]; \
                    s0[i] = ((unsigned)(kc + lo) < 16u) ? a0 : -1e30f; \
                    s1[i] = ((unsigned)(kc + 32 + lo) < 16u) ? a1 : -1e30f; } } \
            float tm = -1e30f; \
            _Pragma("unroll") for (int i = 0; i < 16; ++i) tm = fmaxf(tm, fmaxf(s0[i], s1[i])); \
            tm = fmaxf(tm, __shfl_xor(tm, 32)); \
            const float mnew = fmaxf(mrun, tm), alpha = __builtin_amdgcn_exp2f(mrun - mnew); \
            mrun = mnew; float ls = 0.f; \
            _Pragma("unroll") for (int i = 0; i < 16; ++i) { s0[i] = __builtin_amdgcn_exp2f(s0[i] - mnew); s1[i] = __builtin_amdgcn_exp2f(s1[i] - mnew); ls += s0[i] + s1[i]; } \
            lrun = lrun * alpha + ls; \
            _Pragma("unroll") for (int i = 0; i < 16; ++i) { O0[i] *= alpha; O1[i] *= alpha; } \
            _Pragma("unroll") for (int kt2 = 0; kt2 < 2; ++kt2) \
                _Pragma("unroll") for (int s2 = 0; s2 < 2; ++s2) { \
                    const f32x16& sv = kt2 == 0 ? s0 : s1; \
                    u32x4 pw; pw.x = cvt_pk_bf16(sv[8 * s2 + 0], sv[8 * s2 + 1]); pw.y = cvt_pk_bf16(sv[8 * s2 + 2], sv[8 * s2 + 3]); pw.z = cvt_pk_bf16(sv[8 * s2 + 4], sv[8 * s2 + 5]); pw.w = cvt_pk_bf16(sv[8 * s2 + 6], sv[8 * s2 + 7]); \
                    const bf16x8 pf = __builtin_bit_cast(bf16x8, pw); \
                    const int kof = 32 * kt2 + 16 * s2 + 4 * hh; \
                    const u32x2 va0 = *(const LAS u32x2*)(vb + ((l31) * AT_VS + kof) * 2), va1 = *(const LAS u32x2*)(vb + ((l31) * AT_VS + kof + 8) * 2); \
                    const u32x2 vb0 = *(const LAS u32x2*)(vb + ((32 + l31) * AT_VS + kof) * 2), vb1 = *(const LAS u32x2*)(vb + ((32 + l31) * AT_VS + kof + 8) * 2); \
                    const bf16x8 vf0 = __builtin_bit_cast(bf16x8, (u32x4){va0.x, va0.y, va1.x, va1.y}), vf1 = __builtin_bit_cast(bf16x8, (u32x4){vb0.x, vb0.y, vb1.x, vb1.y}); \
                    O0 = __builtin_amdgcn_mfma_f32_32x32x16_bf16(vf0, pf, O0, 0, 0, 0); \
                    O1 = __builtin_amdgcn_mfma_f32_32x32x16_bf16(vf1, pf, O1, 0, 0, 0); } } } while (0)
    for (int t0 = 0; t0 < nt; t0 += 2) {
        const int cb = (t0 & 2), nb = cb ^ 2;
        if (t0 + 2 < nt) AT_LOAD(t0 + 2, kA, vA);
        if (t0 + 3 < nt) AT_LOAD(t0 + 3, kB, vB);
        AT_COMPUTE(t0, cb);
        if (t0 + 1 < nt) AT_COMPUTE(t0 + 1, cb + 1);
        if (t0 + 2 < nt) AT_WRITE(nb, kA, vA);
        if (t0 + 3 < nt) AT_WRITE(nb + 1, kB, vB);
        __syncthreads();
    }
#undef AT_COMPUTE
#undef AT_LOAD
#undef AT_WRITE
    lrun += __shfl_xor(lrun, 32);
    const float inv = __builtin_amdgcn_rcpf(lrun);
#pragma unroll
    for (int dt = 0; dt < 2; ++dt)
#pragma unroll
        for (int g = 0; g < 4; ++g) { const f32x16& ov = dt == 0 ? O0 : O1; const int dcol = h * 64 + 32 * dt + 8 * g + 4 * hh;
            const u32x2 gq = *(const u32x2*)(GA + qtok * 512 + dcol);
            u32x2 o; o.x = cvt_pk_bf16(ov[4 * g] * inv * bflo(gq.x), ov[4 * g + 1] * inv * bfhi(gq.x)); o.y = cvt_pk_bf16(ov[4 * g + 2] * inv * bflo(gq.y), ov[4 * g + 3] * inv * bfhi(gq.y));
            *(u32x2*)(ACAT + qtok * 1024 + dcol) = o; }
    __syncthreads();
}

constexpr int FS = 144;
__device__ __forceinline__ void four_item(Frame& F, int item) {
    const int tid = F.tid, lane = F.lane, w = F.wave, fr = lane & 15, fq = lane >> 4;
    const int b = item >> 6, cb = item & 63;
    LAS bf16* zT = (LAS bf16*)F.lds;
    LAS bf16* ZP = (LAS bf16*)(F.lds + 256 * FS * 2);
    const bf16* UFL = WSP(bf16, WS_UFL);
#pragma unroll
    for (int q = 0; q < 4; ++q) { const int task = tid + 512 * q, n2 = task & 63, n1q = (task >> 6) & 15, ri = task >> 10;
        const bf16* src = UFL + ((size_t)((b * 2 + ri) * 64 + cb) * 4096 + (size_t)(256 * n1q + n2)) * 4;
        u32x2 t4[4];
#pragma unroll
        for (int i = 0; i < 4; ++i) t4[i] = *(const u32x2*)(src + (size_t)i * 64 * 4);
#pragma unroll
        for (int ch = 0; ch < 4; ++ch) { unsigned e[4];
#pragma unroll
            for (int i = 0; i < 4; ++i) { const unsigned wd = (ch < 2) ? t4[i].x : t4[i].y; e[i] = (ch & 1) ? (wd >> 16) : (wd & 0xffffu); }
            *(LAS u32x2*)(zT + (ch * 64 + n2) * FS + ri * 64 + 4 * n1q) = (u32x2){e[0] | (e[1] << 16), e[2] | (e[3] << 16)}; } }
    __syncthreads();
    {
        const bf16* D1t = WSP(bf16, WS_D1T);
        const float* TW = WSP(float, WS_TW);
#pragma unroll 1
        for (int hp = 0; hp < 2; ++hp) {
            bf16x8 bfv[4][4];
#pragma unroll
            for (int ks = 0; ks < 4; ++ks)
#pragma unroll
                for (int n = 0; n < 4; ++n) { const int nt = 2 * hp + (n & 1) + 4 * (n >> 1); bfv[ks][n] = *(const bf16x8*)(D1t + (16 * nt + fr) * 128 + 32 * ks + 8 * fq); }
            f32x4 tw[2][2][2];
#pragma unroll
            for (int mt = 0; mt < 2; ++mt)
#pragma unroll
                for (int n = 0; n < 2; ++n) { const int n2b = (32 * w + 16 * mt + 4 * fq) & 63, k1 = 16 * (2 * hp + n) + fr;
                    tw[mt][n][0] = *(const f32x4*)(TW + (size_t)(k1 * 64 + n2b) * 2); tw[mt][n][1] = *(const f32x4*)(TW + (size_t)(k1 * 64 + n2b) * 2 + 4); }
            f32x4 acc[2][4];
#pragma unroll
            for (int mt = 0; mt < 2; ++mt)
#pragma unroll
                for (int n = 0; n < 4; ++n) acc[mt][n] = (f32x4){0.f, 0.f, 0.f, 0.f};
#pragma unroll
            for (int ks = 0; ks < 4; ++ks) {
                bf16x8 af[2];
#pragma unroll
                for (int mt = 0; mt < 2; ++mt) af[mt] = *(const LAS bf16x8*)(zT + (32 * w + 16 * mt + fr) * FS + 32 * ks + 8 * fq);
#pragma unroll
                for (int mt = 0; mt < 2; ++mt)
#pragma unroll
                    for (int n = 0; n < 4; ++n) acc[mt][n] = __builtin_amdgcn_mfma_f32_16x16x32_bf16(af[mt], bfv[ks][n], acc[mt][n], 0, 0, 0);
            }
#pragma unroll
            for (int mt = 0; mt < 2; ++mt) { const int M0 = 32 * w + 16 * mt + 4 * fq, ch = M0 >> 6, n2b = M0 & 63;
#pragma unroll
                for (int n = 0; n < 2; ++n) { const int k1 = 16 * (2 * hp + n) + fr;
                    const f32x4 zr = acc[mt][n], zi = acc[mt][n + 2];
                    const f32x4 t0 = tw[mt][n][0], t1 = tw[mt][n][1];
                    const float ct[4] = {t0.x, t0.z, t1.x, t1.z}, st[4] = {t0.y, t0.w, t1.y, t1.w};
                    float pr[4], pi[4];
#pragma unroll
                    for (int e = 0; e < 4; ++e) { pr[e] = zr[e] * ct[e] + zi[e] * st[e]; pi[e] = zi[e] * ct[e] - zr[e] * st[e]; }
                    *(LAS u32x2*)(ZP + (k1 * 4 + ch) * FS + n2b) = (u32x2){cvt_pk_bf16(pr[0], pr[1]), cvt_pk_bf16(pr[2], pr[3])};
                    *(LAS u32x2*)(ZP + (k1 * 4 + ch) * FS + 64 + n2b) = (u32x2){cvt_pk_bf16(pi[0], pi[1]), cvt_pk_bf16(pi[2], pi[3])}; } }
        }
    }
    __syncthreads();
    {
        const bf16* E2t = WSP(bf16, WS_E2T);
        const bf16* GF = WSP(bf16, WS_GF); bf16* ACAT = WSP(bf16, WS_XN);
        bf16x8 bfv[4][4];
#pragma unroll
        for (int ks = 0; ks < 4; ++ks)
#pragma unroll
            for (int n = 0; n < 4; ++n) bfv[ks][n] = *(const bf16x8*)(E2t + (16 * n + fr) * 128 + 32 * ks + 8 * fq);
        u32x2 gq[2][4];
#pragma unroll
        for (int mt = 0; mt < 2; ++mt)
#pragma unroll
            for (int n = 0; n < 4; ++n) { const int k1 = (32 * w + 16 * mt + 4 * fq) >> 2, k2 = 16 * n + fr; gq[mt][n] = *(const u32x2*)(GF + ((size_t)b * SEQ + k1 + 64 * k2) * 256 + 4 * cb); }
        f32x4 acc[2][4];
#pragma unroll
        for (int mt = 0; mt < 2; ++mt)
#pragma unroll
            for (int n = 0; n < 4; ++n) acc[mt][n] = (f32x4){0.f, 0.f, 0.f, 0.f};
#pragma unroll
        for (int ks = 0; ks < 4; ++ks) {
            bf16x8 af[2];
#pragma unroll
            for (int mt = 0; mt < 2; ++mt) af[mt] = *(const LAS bf16x8*)(ZP + (32 * w + 16 * mt + fr) * FS + 32 * ks + 8 * fq);
#pragma unroll
            for (int mt = 0; mt < 2; ++mt)
#pragma unroll
                for (int n = 0; n < 4; ++n) acc[mt][n] = __builtin_amdgcn_mfma_f32_16x16x32_bf16(af[mt], bfv[ks][n], acc[mt][n], 0, 0, 0);
        }
#pragma unroll
        for (int mt = 0; mt < 2; ++mt) { const int k1 = (32 * w + 16 * mt + 4 * fq) >> 2;
#pragma unroll
            for (int n = 0; n < 4; ++n) { const int k2 = 16 * n + fr; const size_t row = (size_t)b * SEQ + k1 + 64 * k2;
                const u32x2 g2 = gq[mt][n]; const f32x4 v = acc[mt][n];
                u32x2 o; o.x = cvt_pk_bf16(v[0] * bflo(g2.x), v[1] * bfhi(g2.x)); o.y = cvt_pk_bf16(v[2] * bflo(g2.y), v[3] * bfhi(g2.y));
                *(u32x2*)(ACAT + row * 1024 + 512 + 4 * cb) = o; } }
    }
    __syncthreads();
}

constexpr int CV_GOFF = 0, CV_UOFF = 49152, CV_AS = 272, CV_US = 260;
__device__ __forceinline__ void conv_item(Frame& F, int item, int layer) {
    const int tid = F.tid, lane = F.lane, w = F.wave, fr = lane & 15, fq = lane >> 4;
    size_t row0; int lo, hi;
    if (item < 256) { const int b = item >> 6; row0 = (size_t)b * SEQ + (item & 63) * 64; lo = b * SEQ; hi = lo + SEQ; }
    else { const int j = item - 256, b = j >> 2; row0 = (size_t)ML + b * CTX + (j & 3) * 64; lo = ML + b * CTX; hi = lo + CTX; }
    const bf16* GLU = WSP(bf16, WS_GLU);
    LAS bf16* gt = (LAS bf16*)(F.lds + CV_GOFF);
    LAS float* U = (LAS float*)(F.lds + CV_UOFF);
    {
        u32x4 gv[6];
#pragma unroll
        for (int q = 0; q < 6; ++q) { const int i = tid + 512 * q, rr = i >> 5, ch = i & 31; const long grow = (long)row0 - 15 + rr;
            const bool ok = (i < 94 * 32) && grow >= lo && grow < hi;
            gv[q] = *(const u32x4*)(GLU + (size_t)(ok ? grow : (long)row0) * 256 + ch * 8);
            if (!ok) gv[q] = (u32x4){0u, 0u, 0u, 0u}; }
#pragma unroll
        for (int q = 0; q < 6; ++q) { const int i = tid + 512 * q; if (i < 94 * 32) *(LAS u32x4*)(gt + (i >> 5) * 256 + (i & 31) * 8) = gv[q]; }
    }
    __syncthreads();
    {
        const int c = tid & 255, th = tid >> 8;
        float wk[31];
#pragma unroll
        for (int t = 0; t < 31; ++t) wk[t] = F_cdw[((size_t)layer * 31 + t) * 256 + c];
        const float bias = F_cdb[layer * 256 + c];
#pragma unroll 1
        for (int q = 0; q < 4; ++q) {
            float a[8];
#pragma unroll
            for (int o = 0; o < 8; ++o) a[o] = bias;
            const LAS bf16* gp = gt + (32 * th + 8 * q) * 256 + c;
#pragma unroll
            for (int j = 0; j < 38; ++j) { const float xv = bf2f(gp[j * 256]);
#pragma unroll
                for (int o = 0; o < 8; ++o) { const int t = j - o; if (t >= 0 && t < 31) a[o] += wk[t] * xv; } }
#pragma unroll
            for (int o = 0; o < 8; ++o) U[(32 * th + 8 * q + o) * CV_US + c] = a[o];
        }
    }
    __syncthreads();
    {
        LAS bf16* At = (LAS bf16*)(F.lds + CV_GOFF);
        const f32x4 g = *(const f32x4*)(F_lng + layer * 256 + 4 * lane), bb = *(const f32x4*)(F_lnb + layer * 256 + 4 * lane);
#pragma unroll
        for (int i = 0; i < 8; ++i) { const int tok = 8 * w + i;
            const f32x4 v = *(const LAS f32x4*)(U + tok * CV_US + 4 * lane);
            const float mean = wave_sum((v.x + v.y) + (v.z + v.w)) * (1.f / 256.f);
            const f32x4 dv = v - mean;
            const float var = wave_sum((dv.x * dv.x + dv.y * dv.y) + (dv.z * dv.z + dv.w * dv.w)) * (1.f / 256.f);
            const float rs = __builtin_amdgcn_rsqf(var + EPS);
            f32x4 y = dv * rs * g + bb;
#pragma unroll
            for (int e = 0; e < 4; ++e) y[e] = fast_silu(y[e]);
            *(LAS u32x2*)(At + tok * CV_AS + 4 * lane) = (u32x2){cvt_pk_bf16(y[0], y[1]), cvt_pk_bf16(y[2], y[3])}; }
    }
    __syncthreads();
    {
        const LAS bf16* At = (const LAS bf16*)(F.lds + CV_GOFF);
        const bf16* Bt = WSP(bf16, WS_BTPW) + (size_t)layer * 65536;
        const bf16* GC = WSP(bf16, WS_GC); bf16* ACAT = WSP(bf16, WS_XN);
        bf16x8 bfv[8][2];
#pragma unroll
        for (int ks = 0; ks < 8; ++ks)
#pragma unroll
            for (int n = 0; n < 2; ++n) bfv[ks][n] = *(const bf16x8*)(Bt + (size_t)(32 * w + 16 * n + fr) * 256 + 32 * ks + 8 * fq);
        u32x2 gq[4][2];
#pragma unroll
        for (int m = 0; m < 4; ++m)
#pragma unroll
            for (int n = 0; n < 2; ++n) gq[m][n] = *(const u32x2*)(GC + (row0 + 16 * m + fr) * 256 + 32 * w + 16 * n + 4 * fq);
        f32x4 acc[4][2];
#pragma unroll
        for (int m = 0; m < 4; ++m)
#pragma unroll
            for (int n = 0; n < 2; ++n) acc[m][n] = (f32x4){0.f, 0.f, 0.f, 0.f};
#pragma unroll
        for (int ks = 0; ks < 8; ++ks) {
            bf16x8 af[4];
#pragma unroll
            for (int m = 0; m < 4; ++m) af[m] = *(const LAS bf16x8*)(At + (16 * m + fr) * CV_AS + 32 * ks + 8 * fq);
#pragma unroll
            for (int m = 0; m < 4; ++m)
#pragma unroll
                for (int n = 0; n < 2; ++n) acc[m][n] = __builtin_amdgcn_mfma_f32_16x16x32_bf16(bfv[ks][n], af[m], acc[m][n], 0, 0, 0);
        }
#pragma unroll
        for (int m = 0; m < 4; ++m)
#pragma unroll
            for (int n = 0; n < 2; ++n) { const size_t row = row0 + 16 * m + fr; const int col = 32 * w + 16 * n + 4 * fq;
                const u32x2 g2 = gq[m][n]; const f32x4 v = acc[m][n];
                u32x2 o; o.x = cvt_pk_bf16(v[0] * bflo(g2.x), v[1] * bfhi(g2.x)); o.y = cvt_pk_bf16(v[2] * bflo(g2.y), v[3] * bfhi(g2.y));
                *(u32x2*)(ACAT + row * 1024 + 768 + col) = o; }
    }
    __syncthreads();
}

__device__ __forceinline__ void panel_sync(unsigned* cnt, unsigned target) {
    asm volatile("s_waitcnt vmcnt(0)" ::: "memory");
    __syncthreads();
    if (threadIdx.x == 0) {
        __builtin_amdgcn_fence(__ATOMIC_RELEASE, "agent");
        asm volatile("s_waitcnt vmcnt(0)" ::: "memory");
        (void)xb_add(cnt, 1u);
        unsigned sp = 0;
        while (xb_ld(cnt) < target) { __builtin_amdgcn_s_sleep(1); if (++sp > (1u << 22)) break; }
        __builtin_amdgcn_fence(__ATOMIC_ACQUIRE, "agent");
        asm volatile("s_waitcnt vmcnt(0)" ::: "memory");
    }
    __syncthreads();
}
__device__ __forceinline__ void ctx_rows(Frame& F, int p, int q) {
    const int lane = F.lane;
    const bf16* YC = WSP(bf16, WS_YC); const float* SSQ = WSP(float, WS_SSQ); bf16* XN = WSP(bf16, WS_XN);
    for (int i = 0; i < 8; ++i) {
        const int cr = 256 * p + 64 * q + 8 * F.wave + i;
        Row16 xv, yv; ld_row_f32(F_ctx + (size_t)cr * D, lane, xv); ld_row_bf16(YC + (size_t)cr * D, lane, yv);
        const float sp = lane < 16 ? SSQ[(size_t)(ML + cr) * 16 + lane] : 0.f;
        const float rs = __builtin_amdgcn_rsqf(wave_sum(sp) * (1.f / D) + EPS);
        Row16 g2; ld_row_f32(WSP(float, WS_MODV) + ((size_t)0 * 5 + 4) * 3072 + 2048, lane, g2);
#pragma unroll
        for (int e = 0; e < 16; ++e) xv.v[e] += g2.v[e] * yv.v[e] * rs;
        float s2 = 0.f;
#pragma unroll
        for (int e = 0; e < 16; ++e) s2 += xv.v[e] * xv.v[e];
        const float rs2 = __builtin_amdgcn_rsqf(wave_sum(s2) * (1.f / D) + EPS);
        Row16 g1, sh; ld_row_f32(WSP(float, WS_MODV) + ((size_t)1 * 5 + 4) * 3072 + 1024, lane, g1); ld_row_f32(WSP(float, WS_MODV) + ((size_t)1 * 5 + 4) * 3072, lane, sh);
#pragma unroll
        for (int e = 0; e < 16; ++e) xv.v[e] = xv.v[e] * rs2 * g1.v[e] + sh.v[e];
        st_row_bf16(XN + (size_t)(ML + cr) * D, lane, xv);
    }
}

__global__ void __launch_bounds__(512, 2) fwd_mega(Args args) {
    extern __shared__ __attribute__((aligned(16))) unsigned char lds_raw[];
    Frame F;
    F.lds = (LAS unsigned char*)lds_raw;
    F.tid = threadIdx.x; F.lane = F.tid & 63; F.wave = __builtin_amdgcn_readfirstlane(F.tid >> 6); F.G = gridDim.x; F.bid = blockIdx.x;
    F.a = (const __attribute__((address_space(4))) Args*)__builtin_amdgcn_kernarg_segment_ptr();
    F.out = args.out; F.ws = args.ws;
    volatile LAS unsigned* MISC = (volatile LAS unsigned*)(F.lds + LDS_MISC);
    if (F.tid < 64) MISC[F.tid] = 0u;
    __syncthreads();
    XcdBarrier bar = xcd_barrier_post((unsigned*)(F.ws + WS_CTL) + 4096, MISC + 8);
    const int lo = args.ph_lo, hi = args.ph_hi;
    int ph = 0;
#define RELAUNDER() { int t_ = threadIdx.x; asm volatile("" : "+v"(t_)); F.tid = t_; F.lane = t_ & 63; F.wave = __builtin_amdgcn_readfirstlane(t_ >> 6); \
        const __attribute__((address_space(4))) Args* a_ = (const __attribute__((address_space(4))) Args*)__builtin_amdgcn_kernarg_segment_ptr(); asm volatile("" : "+s"(a_)); F.a = a_; F.ws = a_->ws; F.out = a_->out; }
#define PHASE_BEGIN if (ph >= lo && ph < hi) { RELAUNDER()
#define PHASE_END   if (ph + 1 < hi) xcd_barrier(bar); } ++ph;
#ifndef REP_P0
#define REP_P0 1
#endif
#ifndef REP_A
#define REP_A 1
#endif
#ifndef REP_B
#define REP_B 1
#endif
#ifndef REP_C1
#define REP_C1 1
#endif
#ifndef REP_C2
#define REP_C2 1
#endif

    PHASE_BEGIN for (int rep = 0; rep < REP_P0; ++rep) p0_prologue(F); PHASE_END
    PHASE_BEGIN for (int rep = 0; rep < REP_P0; ++rep) { row_phase(F, 0); fold_phase(F); } PHASE_END
    for (int layer = 0; layer < 2; ++layer) {
        PHASE_BEGIN for (int rep = 0; rep < REP_A; ++rep) {
            const int GL = layer == 0 ? F.G : F.G - 16;
            EpiIn E{WSP(bf16, WS_Q), WSP(bf16, WS_K), WSP(bf16, WS_VTL), WSP(bf16, WS_VTC), WSP(bf16, WS_GA), WSP(bf16, WS_UFL), WSP(bf16, WS_ZT), WSP(bf16, WS_GF), WSP(bf16, WS_GLU), WSP(bf16, WS_GC), WSP(unsigned char, WS_S)};
            if (F.bid < GL) {
                pg8::Gemm g{WSP(bf16, WS_XN), WSP(bf16, WS_BTIN) + (size_t)layer * NIN * D, D, D};
                SchedA S{GL, F.bid, layer};
                pg8::gemm_phase(F.lds, g, S, E);
            } else {
                const int j = F.bid - GL, p = j >> 2, q = j & 3;
                unsigned* pc = (unsigned*)(F.ws + WS_CTL) + 8192 + 64 * p + 1024 * rep;
                {
                    pg8::Gemm g{WSP(bf16, WS_XN), WSP(bf16, WS_BTCAT), D, D};
                    SchedTile S{64 + p, q, 1}; EpiC1 E1{WSP(bf16, WS_MERGEDC) - (size_t)ML * 1024, WSP(unsigned char, WS_S)};
                    pg8::gemm_phase(F.lds, g, S, E1); }
                panel_sync(pc, 4u);
                {
                    pg8::Gemm g{WSP(bf16, WS_MERGEDC) - (size_t)ML * 1024, WSP(bf16, WS_BTOUT), D, D};
                    SchedTile S{64 + p, q, 0}; EpiC2 E2{WSP(bf16, WS_YC) - (size_t)ML * 1024, WSP(float, WS_SSQ)};
                    pg8::gemm_phase(F.lds, g, S, E2); }
                panel_sync(pc, 8u);
                ctx_rows(F, p, q);
                panel_sync(pc, 12u);
                {
                    pg8::Gemm g{WSP(bf16, WS_XN), WSP(bf16, WS_BTIN) + (size_t)NIN * D, D, D};
                    SchedTile S{64 + p, 2 + q, 0};
                    pg8::gemm_phase(F.lds, g, S, E); }
            } }
        PHASE_END
        PHASE_BEGIN for (int rep = 0; rep < REP_B; ++rep) {
            const int natt = layer == 0 ? 544 : 512;
#ifndef B_MASK
#define B_MASK 31
#endif
#ifndef REP_ATT
#define REP_ATT 1
#endif
#ifndef REP_FOUR
#define REP_FOUR 1
#endif
#ifndef REP_CONV
#define REP_CONV 1
#endif
            if (B_MASK & 1) for (int r2 = 0; r2 < REP_ATT; ++r2) for (int u = F.bid; u < natt; u += F.G) attn_unit(F, u, layer);
            RELAUNDER()
            if (B_MASK & 2) for (int r2 = 0; r2 < REP_FOUR; ++r2) for (int it = F.bid; it < 256; it += F.G) four_item(F, it);
            RELAUNDER()
            if (B_MASK & 4) for (int r2 = 0; r2 < REP_CONV; ++r2) for (int it = F.bid; it < 256; it += F.G) conv_item(F, it, layer);
            RELAUNDER()
            if ((B_MASK & 24) && layer == 0) {
                if ((B_MASK & 16) && F.bid >= 36 && F.bid < 52) conv_item(F, 256 + F.bid - 36, layer);
                if ((B_MASK & 8) && F.bid >= 32 && F.bid < 36) {
                    pg8::Gemm g{WSP(bf16, WS_DCTX), WSP(bf16, WS_ZT), 512, 512};
                    SchedFc S{F.bid - 32}; EpiFc E{WSP(bf16, WS_XN), WSP(bf16, WS_GF)};
                    pg8::gemm_phase(F.lds, g, S, E);
                }
            } }
        PHASE_END
        PHASE_BEGIN
            if (F.bid < 256) {
                int pm, pn; pg8::tile_of(F.bid, 64, 4, pm, pn);
                unsigned* pc = (unsigned*)(F.ws + WS_CTL) + 16384 + layer * 4096 + pm * 64;
                {   pg8::Gemm g{WSP(bf16, WS_XN), WSP(bf16, WS_BTCAT) + (size_t)layer * D * D, D, D};
                    SchedTile S{pm, pn, 1}; EpiC1 E{WSP(bf16, WS_MERGED), WSP(unsigned char, WS_S)};
                    pg8::gemm_phase(F.lds, g, S, E); }
                panel_sync(pc, 4u);
                {   pg8::Gemm g{WSP(bf16, WS_MERGED), WSP(bf16, WS_BTOUT) + (size_t)layer * D * D, D, D};
                    SchedTile S{pm, pn, 0}; EpiC2 E{WSP(bf16, WS_Y), WSP(float, WS_SSQ)};
                    pg8::gemm_phase(F.lds, g, S, E); }
                panel_sync(pc, 8u);
                RELAUNDER()
                row_run(F, layer + 1, pm >> 4, pm * 256 + 64 * pn + 8 * F.wave, 1, 8);
            }
        PHASE_END
    }
}
#ifndef PH_HI
#define PH_HI 8
#endif
constexpr int N_PHASES = PH_HI;

extern "C" void kernel_launch(void* const* d_in, const int* in_sizes, int n_in, void* d_out, int out_size, void* d_ws, size_t ws_size, hipStream_t stream) {
    static int grid = 0;
    if (grid == 0) {
        int dev = 0, cus = 0, per_cu = 0;
        if (n_in != 20 || ws_size < WS_END) { fprintf(stderr, "kernel_launch: unexpected n_in %d / ws %zu\n", n_in, ws_size); grid = -1; return; }
        hipGetDevice(&dev); hipDeviceGetAttribute(&cus, hipDeviceAttributeMultiprocessorCount, dev);
        if (hipFuncSetAttribute((const void*)fwd_mega, hipFuncAttributeMaxDynamicSharedMemorySize, LDS_BYTES) != hipSuccess) { fprintf(stderr, "kernel_launch: hipFuncSetAttribute failed\n"); grid = -1; return; }
        hipOccupancyMaxActiveBlocksPerMultiprocessor(&per_cu, (const void*)fwd_mega, 512, LDS_BYTES);
        (void)hipGetLastError();
        if (per_cu < 1) { fprintf(stderr, "kernel_launch: occupancy query says %d blocks/CU\n", per_cu); grid = -1; return; }
        if (cus < 256) { fprintf(stderr, "kernel_launch: built for a 256-CU device, found %d CUs\n", cus); grid = -1; return; }
        grid = 256;
    }
    if (grid < 0) return;
    hipMemsetAsync((char*)d_ws + WS_CTL, 0, 1 * MiB, stream);
    Args a{};
    for (int i = 0; i < 20; ++i) a.in[i] = (const float*)d_in[i];
    a.out = (float*)d_out; a.ws = (unsigned char*)d_ws; a.ph_lo = 0; a.ph_hi = N_PHASES;
    hipLaunchKernelGGL(fwd_mega, dim3(grid), dim3(512), LDS_BYTES, stream, a);
}
```

```cpp
#include <hip/hip_runtime.h>
#include <cstdio>
#include <cstdint>

#define LAS __attribute__((address_space(3)))
typedef unsigned short bf16;
typedef short bf16x8 __attribute__((ext_vector_type(8)));
typedef float f32x4 __attribute__((ext_vector_type(4)));
typedef float f32x16 __attribute__((ext_vector_type(16)));
typedef unsigned u32x4 __attribute__((ext_vector_type(4)));
typedef unsigned u32x2 __attribute__((ext_vector_type(2)));

constexpr int D = 1024, NB = 4, SEQ = 4096, CTX = 256, NH = 8;
constexpr int ML = NB * SEQ, MC = NB * CTX, MT = ML + MC;
constexpr int INW = 6400, NIN = 6656;
constexpr int OUF = 2048, OCA = 2560, OCB = 2816;
constexpr float EPS = 1e-6f;
constexpr float QSCALE = 0.125f * 1.44269504088896f;
constexpr float LOG2E = 1.44269504088896f;

constexpr size_t KiB = 1024, MiB = 1024 * 1024;
constexpr size_t WS_CTL = 0;
constexpr size_t WS_MODV = 1 * MiB;
constexpr size_t WS_WCS = WS_MODV + 128 * KiB;
constexpr size_t WS_D1T = WS_WCS + 1 * MiB;
constexpr size_t WS_E2T = WS_D1T + 32 * KiB;
constexpr size_t WS_TW = WS_E2T + 16 * KiB;
constexpr size_t WS_DCTX = WS_TW + 32 * KiB;
constexpr size_t WS_SSQ = WS_DCTX + 256 * KiB;
constexpr size_t WS_CTX1 = WS_SSQ + 1088 * KiB;
constexpr size_t WS_BTIN = 8 * MiB;
constexpr size_t WS_BTCAT = WS_BTIN + 26 * MiB;
constexpr size_t WS_BTOUT = WS_BTCAT + 4 * MiB;
constexpr size_t WS_BTPW = WS_BTOUT + 4 * MiB;
constexpr size_t WS_XN = 43 * MiB;
constexpr size_t WS_Q = WS_XN + 34 * MiB;
constexpr size_t WS_K = WS_Q + 17 * MiB;
constexpr size_t WS_MERGED = WS_Q;
constexpr size_t WS_VTL = WS_K + 17 * MiB;
constexpr size_t WS_VTC = WS_VTL + 16 * MiB;
constexpr size_t WS_GA = WS_VTC + 1 * MiB;
constexpr size_t WS_Y = WS_VTL;
constexpr size_t WS_UFL = WS_GA + 17 * MiB;
constexpr size_t WS_ZT = WS_UFL + 16 * MiB;
constexpr size_t WS_GF = WS_ZT + 1 * MiB;
constexpr size_t WS_GLU = WS_GF + 8704 * KiB;
constexpr size_t WS_GC = WS_GLU + 8704 * KiB;
constexpr size_t WS_S = WS_GC + 8704 * KiB;
constexpr size_t WS_MERGEDC = WS_S + 51 * MiB;
constexpr size_t WS_YC = WS_MERGEDC + 2 * MiB;
constexpr size_t WS_AFL = WS_YC + 2 * MiB;
constexpr size_t WS_END = WS_AFL + 8 * MiB;
static_assert(WS_CTX1 + 4 * MiB <= WS_BTIN && WS_BTPW + 256 * KiB <= WS_XN && WS_END <= 256 * MiB, "ws map");

constexpr int LDS_MISC = 147456;
constexpr int LDS_BYTES = 147456 + 1024;

typedef __bf16 bf16x2_t __attribute__((ext_vector_type(2)));
__device__ __forceinline__ unsigned cvt_pk_bf16(float lo, float hi) { bf16x2_t v; v.x = (__bf16)lo; v.y = (__bf16)hi; return __builtin_bit_cast(unsigned, v); }
__device__ __forceinline__ unsigned f2bf(float f) { unsigned u = __builtin_bit_cast(unsigned, f); return (u + 0x7fffu + ((u >> 16) & 1u)) >> 16; }
__device__ __forceinline__ float bflo(unsigned u) { return __builtin_bit_cast(float, u << 16); }
__device__ __forceinline__ float bfhi(unsigned u) { return __builtin_bit_cast(float, u & 0xffff0000u); }
__device__ __forceinline__ float bf2f(bf16 b) { return __builtin_bit_cast(float, (unsigned)b << 16); }
__device__ __forceinline__ float fast_sigmoid(float v) { return __builtin_amdgcn_rcpf(1.f + __builtin_amdgcn_exp2f(-v * LOG2E)); }
__device__ __forceinline__ float fast_silu(float v) { return v * fast_sigmoid(v); }
template <int CTRL, int ROWMASK> __device__ __forceinline__ float dpp_term(float v) {
    return __builtin_bit_cast(float, __builtin_amdgcn_update_dpp(0, __builtin_bit_cast(int, v), CTRL, ROWMASK, 0xf, false));
}
__device__ __forceinline__ float wave_sum(float v) {
    v += dpp_term<0xB1, 0xf>(v);
    v += dpp_term<0x4E, 0xf>(v);
    v += dpp_term<0x141, 0xf>(v);
    v += dpp_term<0x140, 0xf>(v);
    v += dpp_term<0x142, 0xa>(v);
    v += dpp_term<0x143, 0xc>(v);
    return __builtin_bit_cast(float, __builtin_amdgcn_readlane(__builtin_bit_cast(int, v), 63));
}
__device__ __forceinline__ void wave_sum8(float (&v)[8]) {
#pragma unroll
    for (int i = 0; i < 8; ++i) v[i] += dpp_term<0xB1, 0xf>(v[i]);
#pragma unroll
    for (int i = 0; i < 8; ++i) v[i] += dpp_term<0x4E, 0xf>(v[i]);
#pragma unroll
    for (int i = 0; i < 8; ++i) v[i] += dpp_term<0x141, 0xf>(v[i]);
#pragma unroll
    for (int i = 0; i < 8; ++i) v[i] += dpp_term<0x140, 0xf>(v[i]);
#pragma unroll
    for (int i = 0; i < 8; ++i) v[i] += dpp_term<0x142, 0xa>(v[i]);
#pragma unroll
    for (int i = 0; i < 8; ++i) v[i] += dpp_term<0x143, 0xc>(v[i]);
#pragma unroll
    for (int i = 0; i < 8; ++i) v[i] = __builtin_bit_cast(float, __builtin_amdgcn_readlane(__builtin_bit_cast(int, v[i]), 63));
}
#define LDS_WAIT() asm volatile("s_waitcnt lgkmcnt(0)" ::: "memory")
#define VM_WAIT() asm volatile("s_waitcnt vmcnt(0)" ::: "memory")

namespace pg8 {
constexpr int BM = 256, BK = 64, HALF = 128, HTB = HALF * BK * 2, STAGE_BYTES = 8 * HTB, NXCD = 8, WGM = 8;
__device__ __forceinline__ int lds_byte(int r, int c) { const int st = (r >> 4) * 2 + (c >> 5), rr = r & 15, cc = c & 31, ob = rr * 64 + cc * 2; return st * 1024 + (ob ^ (((ob >> 9) & 1) << 5)); }
__device__ __forceinline__ void stage_rc(int b, int& R, int& C) { const int st = b / 1024, sb = b % 1024, swz = sb ^ (((sb >> 9) & 1) << 5); R = (st >> 1) * 16 + swz / 64; C = (st & 1) * 32 + (swz % 64) / 2; }
__device__ __forceinline__ int perm32(int rho) { const int n = rho >> 4, i = rho & 15; return 8 * (i >> 2) + 4 * n + (i & 3); }

struct Unit { int pm, pn, k0, nt, tag, amode; };
struct Gemm { const bf16* A; const bf16* Bt; int lda, ldb; unsigned long long* ts = nullptr; const bf16* A2 = nullptr; };

__device__ __forceinline__ void tile_of(int L, int nM, int nN, int& pm, int& pn) {
    const int nwg = nM * nN; int wgid = L; { const int q = nwg / NXCD, r = nwg % NXCD, xcd = wgid % NXCD, off = wgid / NXCD; wgid = (xcd < r ? xcd * (q + 1) : r * (q + 1) + (xcd - r) * q) + off; }
    const int nig = WGM * nN, gid = wgid / nig, fm = gid * WGM, gsz = (nM - fm) < WGM ? (nM - fm) : WGM;
    pm = fm + ((wgid % nig) % gsz); pn = (wgid % nig) / gsz;
}

struct APar { const char* base; unsigned kstep, hstep, d1, vo; };
template <bool SWAP = false, bool AMODES = false, class Epi, class Sched>
__device__ __forceinline__ void gemm_phase(LAS unsigned char* lds, const Gemm g, const Sched& S, const Epi& E) {
    int tid_ = threadIdx.x; asm volatile("" : "+v"(tid_));
    const int tid = tid_, wid = __builtin_amdgcn_readfirstlane(tid >> 6), lane = tid & 63, wr = wid >> 2, wc = wid & 3, fr = lane & 15, fq = lane >> 4;
    unsigned voffB[2]; unsigned vo0, vo1;
    { int R, C; stage_rc(tid * 16, R, C); vo0 = (unsigned)(R * g.lda + C) * 2u; vo1 = (unsigned)((C >> 3) * 4096 + R) * 16u;
#pragma unroll
      for (int i = 0; i < 2; ++i) { int R2, C2; stage_rc(tid * 16 + i * 8192, R2, C2); const int Rb = (R2 & ~31) + perm32(R2 & 31); voffB[i] = (unsigned)(Rb * g.ldb + C2) * 2u; } }
    const size_t kstep = (size_t)(BK * 2);
    const size_t hstepB = (size_t)HALF * g.ldb * 2;
    const unsigned ldsw = (unsigned)wid * 1024u;
    const int aoff = lds_byte(wr * 64 + fr, fq * 8), boff = lds_byte(wc * 32 + fr, fq * 8);
#define PG8_APAR(P, u) do { if (AMODES && (u).amode) { (P).base = (const char*)g.A2 + ((size_t)(((u).pm >> 4) * 32 + (((u).k0 - 512) >> 3)) * 4096 + (size_t)(((u).pm & 15) * 256)) * 16; \
            (P).kstep = 8u * 4096u * 16u; (P).hstep = 2048u; (P).d1 = 1024u; (P).vo = vo1; } \
        else { (P).base = (const char*)(g.A + (size_t)(u).pm * BM * g.lda + (u).k0); (P).kstep = (unsigned)(BK * 2); (P).hstep = (unsigned)(HALF * g.lda * 2); (P).d1 = (unsigned)(64 * g.lda * 2); (P).vo = vo0; } } while (0)
#define PG8_SA(b, h) (((b) * 2 + (h)) * HTB)
#define PG8_SB(b, h) ((4 + (b) * 2 + (h)) * HTB)
#define PG8_STAGE(bufoff, gbase, voff) do { _Pragma("unroll") for (int _i = 0; _i < 2; ++_i) \
        __builtin_amdgcn_global_load_lds((const unsigned*)((const char*)(gbase) + (voff)[_i]), (LAS unsigned*)(lds + (bufoff) + ldsw + _i * 8192), 16, 0, 0); } while (0)
#define PG8_STAGE_A(bufoff, gbase, P) do { \
        __builtin_amdgcn_global_load_lds((const unsigned*)((const char*)(gbase) + (P).vo), (LAS unsigned*)(lds + (bufoff) + ldsw), 16, 0, 0); \
        __builtin_amdgcn_global_load_lds((const unsigned*)((const char*)(gbase) + (P).d1 + (P).vo), (LAS unsigned*)(lds + (bufoff) + ldsw + 8192), 16, 0, 0); } while (0)
#define PG8_LDA(dst, b, h) do { _Pragma("unroll") for (int m = 0; m < 4; ++m) _Pragma("unroll") for (int k = 0; k < 2; ++k) dst[m][k] = *(const LAS bf16x8*)(lds + PG8_SA(b, h) + aoff + m * 2048 + k * 1024); } while (0)
#define PG8_LDB(dst, b, h) do { _Pragma("unroll") for (int n = 0; n < 2; ++n) _Pragma("unroll") for (int k = 0; k < 2; ++k) dst[n][k] = *(const LAS bf16x8*)(lds + PG8_SB(b, h) + boff + n * 2048 + k * 1024); } while (0)
#define PG8_MMA(ai, bj, At, Bt) do { __builtin_amdgcn_s_setprio(1); _Pragma("unroll") for (int m = 0; m < 4; ++m) _Pragma("unroll") for (int n = 0; n < 2; ++n) _Pragma("unroll") for (int k = 0; k < 2; ++k) \
        acc[ai][bj][m][n] = SWAP ? __builtin_amdgcn_mfma_f32_16x16x32_bf16(At[m][k], Bt[n][k], acc[ai][bj][m][n], 0, 0, 0) : __builtin_amdgcn_mfma_f32_16x16x32_bf16(Bt[n][k], At[m][k], acc[ai][bj][m][n], 0, 0, 0); __builtin_amdgcn_s_setprio(0); } while (0)
#define PG8_WAIT_V(n) asm volatile("s_waitcnt vmcnt(" #n ")" ::: "memory")
#define PG8_WAIT_L(n) asm volatile("s_waitcnt lgkmcnt(" #n ")" ::: "memory")
#define PG8_BAR __builtin_amdgcn_s_barrier()
#define PG8_SCHED __builtin_amdgcn_sched_barrier(0)
    Unit cur{}, nxt{}; int ui = 0;
    if (!S.next(0, cur)) return;
    f32x4 acc[2][2][4][2];
#pragma unroll
    for (int a = 0; a < 2; ++a)
#pragma unroll
        for (int b = 0; b < 2; ++b)
#pragma unroll
            for (int m = 0; m < 4; ++m)
#pragma unroll
                for (int n = 0; n < 2; ++n) acc[a][b][m][n] = (f32x4){0.f, 0.f, 0.f, 0.f};
    bf16x8 At[4][2], B0[2][2], B1[2][2];
    APar pc; PG8_APAR(pc, cur);
    const char* cB = (const char*)(g.Bt + (size_t)cur.pn * BM * g.ldb + cur.k0);
    PG8_STAGE(PG8_SB(0, 0), cB, voffB); PG8_STAGE(PG8_SB(0, 1), cB + hstepB, voffB); PG8_STAGE_A(PG8_SA(0, 0), pc.base, pc); PG8_STAGE_A(PG8_SA(0, 1), pc.base + pc.hstep, pc);
    if (wr == 1) PG8_BAR;
    PG8_WAIT_V(2); PG8_BAR;
    PG8_STAGE(PG8_SB(1, 0), cB + kstep, voffB); PG8_STAGE_A(PG8_SA(1, 0), pc.base + pc.kstep, pc); PG8_STAGE(PG8_SB(1, 1), cB + hstepB + kstep, voffB);
    PG8_WAIT_V(6); PG8_BAR;
    for (;;) {
        const bool has_next = S.next(ui + 1, nxt);
        APar pn2 = pc; if (has_next) PG8_APAR(pn2, nxt);
        const char* nB = has_next ? (const char*)(g.Bt + (size_t)nxt.pn * BM * g.ldb + nxt.k0) : cB;
        const int nt = cur.nt;
        for (int t = 0; t < nt; t += 2) {
            const bool last = (t == nt - 2);
            const char* a1 = pc.base + (size_t)(t + 1) * pc.kstep;
            APar p2; p2.base = last ? pn2.base : pc.base + (size_t)(t + 2) * pc.kstep; p2.kstep = last ? pn2.kstep : pc.kstep; p2.hstep = last ? pn2.hstep : pc.hstep; p2.d1 = last ? pn2.d1 : pc.d1; p2.vo = last ? pn2.vo : pc.vo;
            const char* b2 = last ? nB : cB + (size_t)(t + 2) * kstep;
            const char* a3 = p2.base + p2.kstep; const char* b3 = b2 + kstep;
            PG8_LDB(B0, 0, 0); PG8_LDB(B1, 0, 1); PG8_SCHED; PG8_LDA(At, 0, 0); PG8_STAGE_A(PG8_SA(1, 1), a1 + pc.hstep, pc);
            PG8_WAIT_V(8); PG8_WAIT_L(0); PG8_BAR; PG8_MMA(0, 0, At, B0); PG8_MMA(0, 1, At, B1); PG8_BAR; PG8_SCHED;
            PG8_LDA(At, 0, 1); PG8_STAGE(PG8_SB(0, 0), b2, voffB); PG8_STAGE(PG8_SB(0, 1), b2 + hstepB, voffB); PG8_STAGE_A(PG8_SA(0, 0), p2.base, p2);
            PG8_WAIT_V(8); PG8_WAIT_L(0); PG8_BAR; PG8_MMA(1, 0, At, B0); PG8_MMA(1, 1, At, B1); PG8_BAR; PG8_SCHED;
            PG8_LDB(B0, 1, 0); PG8_LDB(B1, 1, 1); PG8_SCHED; PG8_LDA(At, 1, 0); PG8_STAGE_A(PG8_SA(0, 1), p2.base + p2.hstep, p2);
            PG8_WAIT_V(8); PG8_WAIT_L(0); PG8_BAR; PG8_MMA(0, 0, At, B0); PG8_MMA(0, 1, At, B1); PG8_BAR; PG8_SCHED;
            PG8_LDA(At, 1, 1); PG8_STAGE(PG8_SB(1, 0), b3, voffB); PG8_STAGE(PG8_SB(1, 1), b3 + hstepB, voffB); PG8_STAGE_A(PG8_SA(1, 0), a3, p2);
            PG8_WAIT_V(8); PG8_WAIT_L(0); PG8_BAR; PG8_MMA(1, 0, At, B0); PG8_MMA(1, 1, At, B1); PG8_BAR; PG8_SCHED;
        }
#if defined(TS_MG)
        if (g.ts && tid == 0 && (int)blockIdx.x == TS_WG && TS_MG == 70 + 2 * ui) g.ts[70 + 2 * ui] = __builtin_amdgcn_s_memrealtime();
#endif
        if (wr == 0) PG8_BAR;
        const bool keep = E(acc, cur, wr, wc, fr, fq);
#if defined(TS_MG)
        if (g.ts && tid == 0 && (int)blockIdx.x == TS_WG && TS_MG == 71 + 2 * ui) g.ts[71 + 2 * ui] = __builtin_amdgcn_s_memrealtime();
#endif
        if (!has_next) break;
        if (!keep) {
#pragma unroll
        for (int a = 0; a < 2; ++a)
#pragma unroll
            for (int b = 0; b < 2; ++b)
#pragma unroll
                for (int m = 0; m < 4; ++m)
#pragma unroll
                    for (int n = 0; n < 2; ++n) acc[a][b][m][n] = (f32x4){0.f, 0.f, 0.f, 0.f}; }
        cur = nxt; pc = pn2; cB = nB; ++ui;
        if (wr == 1) PG8_BAR;
    }
    PG8_WAIT_V(0);
    PG8_BAR;
#undef PG8_SA
#undef PG8_SB
#undef PG8_STAGE
#undef PG8_STAGE_A
#undef PG8_APAR
#undef PG8_LDA
#undef PG8_LDB
#undef PG8_MMA
#undef PG8_WAIT_V
#undef PG8_WAIT_L
#undef PG8_BAR
#undef PG8_SCHED
}
}
using pg8::Unit;
typedef f32x4 (&AccRef)[2][2][4][2];

#define XB_TMO      128
#define XB_XCNT(j)  (256  + 64 * (j))
#define XB_XSUB(j)  (1280 + 64 * (j))
#define XB_XGEN(j)  (2304 + 64 * (j))
#define XB_TOP      3328
#define XB_TOPGEN   3392
#define XCD_BAR_WORDS 3456
#define XB_SPIN_CAP (1u << 18)
__device__ __forceinline__ unsigned xb_ld(unsigned* p)              { return __hip_atomic_load(p, __ATOMIC_RELAXED, __HIP_MEMORY_SCOPE_AGENT); }
__device__ __forceinline__ unsigned xb_add(unsigned* p, unsigned v) { return __hip_atomic_fetch_add(p, v, __ATOMIC_RELAXED, __HIP_MEMORY_SCOPE_AGENT); }
__device__ __forceinline__ unsigned xb_xcc_id() { return (unsigned)__builtin_amdgcn_s_getreg((3 << 11) | 20) & 0xFu; }
#define XB_SPIN(cond, bar) do { unsigned _sp = 0; while (cond) { __builtin_amdgcn_s_sleep(1); \
    if ((++_sp & 255u) == 0u) { if (xb_ld(&(bar)[XB_TMO])) break; if (_sp > XB_SPIN_CAP) { atomicAdd(&(bar)[XB_TMO], 1u); break; } } } } while (0)
struct XcdBarrier { unsigned* bar; unsigned x; volatile LAS unsigned* st; };
__device__ __forceinline__ XcdBarrier xcd_barrier_post(unsigned* bar, volatile LAS unsigned* st) {
    XcdBarrier b; b.bar = bar; b.x = xb_xcc_id(); b.st = st;
    if (threadIdx.x == 0) (void)xb_add(&bar[XB_XCNT(b.x)], 1u);
    return b;
}
__device__ __forceinline__ void xcd_barrier_complete(unsigned* bar, unsigned x, unsigned& nloc, unsigned& nx) {
    const unsigned G = gridDim.x * gridDim.y * gridDim.z;
    unsigned sum, cnt, mine, sp = 0u;
    for (;;) {
        sum = 0u; cnt = 0u; mine = 0u;
#pragma unroll
        for (unsigned j = 0; j < 16; ++j) { const unsigned c = xb_ld(&bar[XB_XCNT(j)]); sum += c; cnt += (c > 0u) ? 1u : 0u; mine = (j == x) ? c : mine; }
        if (sum == G) break;
        __builtin_amdgcn_s_sleep(1);
        if ((++sp & 255u) == 0u) { if (xb_ld(&bar[XB_TMO])) break; if (sp > XB_SPIN_CAP) { atomicAdd(&bar[XB_TMO], 1u); break; } }
    }
    nloc = mine > 0u ? mine : 1u; nx = cnt > 0u ? cnt : 1u;
}
__device__ __forceinline__ void xcd_barrier(const XcdBarrier& b) {
    asm volatile("s_waitcnt vmcnt(0)" ::: "memory");
    __syncthreads();
    if (b.st[0] == 0u) {
        if (threadIdx.x < 64) {
            const unsigned G = gridDim.x * gridDim.y * gridDim.z; const unsigned lane = threadIdx.x; unsigned sp = 0u, c = 0u; float sum = 0.f, cnt = 0.f;
            for (;;) {
                c = lane < 16u ? xb_ld(&b.bar[XB_XCNT(lane)]) : 0u;
                sum = wave_sum((float)c); cnt = wave_sum(c > 0u ? 1.f : 0.f);
                if ((unsigned)sum == G) break;
                __builtin_amdgcn_s_sleep(1);
                if ((++sp & 255u) == 0u) { if (xb_ld(&b.bar[XB_TMO])) break; if (sp > XB_SPIN_CAP) { if (lane == 0u) atomicAdd(&b.bar[XB_TMO], 1u); break; } }
            }
            const unsigned mine = (unsigned)__builtin_amdgcn_readlane((int)c, (int)__builtin_amdgcn_readfirstlane((int)b.x)), nxc = (unsigned)cnt;
            if (lane == 0u) { b.st[0] = mine > 0u ? mine : 1u; b.st[1] = nxc > 0u ? nxc : 1u; }
        }
        __syncthreads();
    }
    if (threadIdx.x == 0) {
        unsigned* bar = b.bar;
        __builtin_amdgcn_s_waitcnt(0);
        const unsigned nloc = b.st[0], nx = b.st[1];
        const unsigned old = xb_add(&bar[XB_XSUB(b.x)], 1u);
        const unsigned gen = old / nloc;
        if (old + 1u == (gen + 1u) * nloc) {
            __builtin_amdgcn_fence(__ATOMIC_RELEASE, "agent");
            asm volatile("s_waitcnt vmcnt(0)" ::: "memory");
            const unsigned og = xb_add(&bar[XB_TOP], 1u);
            const unsigned tg = og / nx;
            if (og + 1u == (tg + 1u) * nx) xb_add(&bar[XB_TOPGEN], 1u);
            else XB_SPIN(xb_ld(&bar[XB_TOPGEN]) == tg, bar);
            __builtin_amdgcn_fence(__ATOMIC_ACQUIRE, "agent");
            xb_add(&bar[XB_XGEN(b.x)], 1u);
            asm volatile("s_waitcnt vmcnt(0)" ::: "memory");
        } else {
            XB_SPIN(xb_ld(&bar[XB_XGEN(b.x)]) == gen, bar);
            __builtin_amdgcn_fence(__ATOMIC_ACQUIRE, "agent");
            asm volatile("s_waitcnt vmcnt(0)" ::: "memory");
        }
    }
    __syncthreads();
}

__device__ __forceinline__ void flag_signal(unsigned* cnt) {
    asm volatile("s_waitcnt vmcnt(0)" ::: "memory");
    __syncthreads();
    if (threadIdx.x == 0) { __builtin_amdgcn_fence(__ATOMIC_RELEASE, "agent"); asm volatile("s_waitcnt vmcnt(0)" ::: "memory"); (void)xb_add(cnt, 1u); }
}
__device__ __forceinline__ void flag_wait(unsigned* cnt, unsigned target) {
    if (threadIdx.x == 0) { unsigned sp = 0; while (xb_ld(cnt) < target) { __builtin_amdgcn_s_sleep(2); if (++sp > (1u << 22)) break; }
        __builtin_amdgcn_fence(__ATOMIC_ACQUIRE, "agent"); asm volatile("s_waitcnt vmcnt(0)" ::: "memory"); }
    __syncthreads();
}
struct Args { const float* in[20]; float* out; unsigned char* ws; int ph_lo, ph_hi; };
struct Frame {
    LAS unsigned char* lds;
    int tid, lane, wave, G, bid;
    const __attribute__((address_space(4))) Args* a;
    float* out; unsigned char* ws;
};
#define F_x (F.a->in[0])
#define F_c (F.a->in[1])
#define F_ctx (F.a->in[2])
#define F_cctx (F.a->in[3])
#define F_wmod (F.a->in[4])
#define F_bmod (F.a->in[5])
#define F_gpre (F.a->in[6])
#define F_gpost (F.a->in[7])
#define F_win (F.a->in[8])
#define F_rpb (F.a->in[9])
#define F_wfour (F.a->in[10])
#define F_cdw (F.a->in[11])
#define F_cdb (F.a->in[12])
#define F_lng (F.a->in[13])
#define F_lnb (F.a->in[14])
#define F_wpw (F.a->in[15])
#define F_pattn (F.a->in[16])
#define F_pfour (F.a->in[17])
#define F_pconv (F.a->in[18])
#define F_wout (F.a->in[19])
#define WSP(T, off) ((T*)(F.ws + (off)))
#ifdef TS_A
#define TS_REC() do { if (F.bid == 0 && threadIdx.x == 0) ((unsigned long long*)(F.ws + WS_CTL + 512 * 1024))[ph + 1] = __builtin_amdgcn_s_memrealtime(); } while (0)
#define TS_MARK(slot) do { if (threadIdx.x == 0) { unsigned long long* tp_ = (unsigned long long*)(F.ws + WS_CTL + 512 * 1024) + (slot); if (TS_WG == -2) atomicMax(tp_, ((unsigned long long)__builtin_amdgcn_s_memrealtime() << 9) | (unsigned long long)F.bid); else if (TS_WG < 0) atomicMax(tp_, (unsigned long long)__builtin_amdgcn_s_memrealtime()); else if (F.bid == TS_WG) *tp_ = __builtin_amdgcn_s_memrealtime(); } } while (0)
#else
#define TS_REC() do { } while (0)
#define TS_MARK(slot) do { } while (0)
#endif

__device__ __forceinline__ int win_dstrow(int c) {
    if (c < 2048) return c;
    if (c < 2304) return -1;
    if (c < 2560) return c + 256;
    if (c < 2816) { const int j = c - 2560; return 2816 + (j >> 7) * 256 + (j & 127); }
    if (c < 3072) { const int j = c - 2816; return 2816 + (j >> 7) * 256 + 128 + (j & 127); }
    return c + 256;
}
__device__ __forceinline__ void transpose_item(const float* W, int ldw, int k0, int n0, bf16* dst, int ldk, int dstrow0, int dstk0, LAS float* scr, int lane) {
#pragma unroll
    for (int i = 0; i < 32; ++i) { const int kk = 2 * i + (lane >> 5); scr[kk * 33 + (lane & 31)] = W[(size_t)(k0 + kk) * ldw + n0 + (lane & 31)]; }
    LDS_WAIT(); asm volatile("" ::: "memory");
    const int c = lane & 7;
#pragma unroll
    for (int j = 0; j < 4; ++j) { const int n = (lane >> 3) + 8 * j; const LAS float* s = scr + (8 * c) * 33 + n;
        u32x4 o; o.x = cvt_pk_bf16(s[0], s[33]); o.y = cvt_pk_bf16(s[66], s[99]); o.z = cvt_pk_bf16(s[132], s[165]); o.w = cvt_pk_bf16(s[198], s[231]);
        *(u32x4*)(dst + (size_t)(dstrow0 + n) * ldk + dstk0 + k0 + 8 * c) = o; }
    LDS_WAIT(); asm volatile("" ::: "memory");
}
struct TDesc { const float* src; bf16* dst; int ldw, ldk; };
__device__ __forceinline__ void t_desc(Frame& F, int it, TDesc& d) {
    const int l = it / 4128; int r = it % 4128;
    if (r < 3072) { const int kb = r / 192, nb0 = r % 192, nb = nb0 < 64 ? nb0 : nb0 + 8; const int dr = win_dstrow(nb * 32);
        d.src = F_win + (size_t)l * D * INW + (size_t)(kb * 64) * INW + nb * 32; d.ldw = INW; d.dst = WSP(bf16, WS_BTIN) + (size_t)l * NIN * D + (size_t)dr * D + kb * 64; d.ldk = D; return; } r -= 3072;
    if (r < 256) { d.src = F_pattn + (size_t)l * 512 * D + (size_t)((r / 32) * 64) * D + (r % 32) * 32; d.ldw = D; d.dst = WSP(bf16, WS_BTCAT) + (size_t)l * D * D + (size_t)((r % 32) * 32) * D + (r / 32) * 64; d.ldk = D; return; } r -= 256;
    if (r < 128) { d.src = F_pfour + (size_t)l * 256 * D + (size_t)((r / 32) * 64) * D + (r % 32) * 32; d.ldw = D; d.dst = WSP(bf16, WS_BTCAT) + (size_t)l * D * D + (size_t)((r % 32) * 32) * D + 512 + (r / 32) * 64; d.ldk = D; return; } r -= 128;
    if (r < 128) { d.src = F_pconv + (size_t)l * 256 * D + (size_t)((r / 32) * 64) * D + (r % 32) * 32; d.ldw = D; d.dst = WSP(bf16, WS_BTCAT) + (size_t)l * D * D + (size_t)((r % 32) * 32) * D + 768 + (r / 32) * 64; d.ldk = D; return; } r -= 128;
    if (r < 512) { d.src = F_wout + (size_t)l * D * D + (size_t)((r / 32) * 64) * D + (r % 32) * 32; d.ldw = D; d.dst = WSP(bf16, WS_BTOUT) + (size_t)l * D * D + (size_t)((r % 32) * 32) * D + (r / 32) * 64; d.ldk = D; return; } r -= 512;
    d.src = F_wpw + (size_t)l * 65536 + (size_t)((r / 8) * 64) * 256 + (r % 8) * 32; d.ldw = 256; d.dst = WSP(bf16, WS_BTPW) + (size_t)l * 65536 + (size_t)((r % 8) * 32) * 256 + (r / 8) * 64; d.ldk = 256;
}
__device__ __forceinline__ void t_load(const TDesc& d, int lane, float (&v)[32]) {
#pragma unroll
    for (int i = 0; i < 32; ++i) v[i] = d.src[(size_t)(2 * i + (lane >> 5)) * d.ldw + (lane & 31)];
}
__device__ __forceinline__ void t_store(const TDesc& d, int lane, const float (&v)[32], LAS float* scr) {
#pragma unroll
    for (int i = 0; i < 32; ++i) scr[(2 * i + (lane >> 5)) * 33 + (lane & 31)] = v[i];
    LDS_WAIT(); asm volatile("" ::: "memory");
    const int c = lane & 7;
#pragma unroll
    for (int j = 0; j < 4; ++j) { const int n = (lane >> 3) + 8 * j; const LAS float* sp = scr + (8 * c) * 33 + n;
        u32x4 o; o.x = cvt_pk_bf16(sp[0], sp[33]); o.y = cvt_pk_bf16(sp[66], sp[99]); o.z = cvt_pk_bf16(sp[132], sp[165]); o.w = cvt_pk_bf16(sp[198], sp[231]);
        *(u32x4*)(d.dst + (size_t)n * d.ldk + 8 * c) = o; }
    LDS_WAIT(); asm volatile("" ::: "memory");
}
__device__ __forceinline__ void p0_prologue(Frame& F) {
    LAS float* scr = (LAS float*)(F.lds + F.wave * 16384);
    const int gw = F.bid * 8 + F.wave, NGW = F.G * 8, lane = F.lane;
    if (F.bid < 96) {
        LAS float* sc = (LAS float*)F.lds;
        LAS float* red = sc + 5 * 1024;
        for (int i = F.tid; i < 5 * 1024; i += 512) { const int r = i >> 10, k = i & 1023; sc[i] = fast_silu(r < 4 ? F_c[r * D + k] : F_cctx[k]); }
        __syncthreads();
        const int l = F.bid / 48, n = (F.bid % 48) * 64 + lane;
        const float* w = F_wmod + (size_t)l * D * 3072 + (size_t)(128 * F.wave) * 3072 + n;
        const LAS float* scw = sc + 128 * F.wave;
        float a0 = 0.f, a1 = 0.f, a2 = 0.f, a3 = 0.f, a4 = 0.f;
#pragma unroll 16
        for (int k = 0; k < 128; ++k) { const float wv = w[(size_t)k * 3072];
            a0 += scw[k] * wv; a1 += scw[1024 + k] * wv; a2 += scw[2048 + k] * wv; a3 += scw[3072 + k] * wv; a4 += scw[4096 + k] * wv; }
        LAS float* rw = red + (F.wave * 5) * 64 + lane;
        rw[0] = a0; rw[64] = a1; rw[128] = a2; rw[192] = a3; rw[256] = a4;
        __syncthreads();
        if (F.tid < 320) { const int q = F.tid >> 6;
            float v = 0.f;
#pragma unroll
            for (int ww = 0; ww < 8; ++ww) v += red[(ww * 5 + q) * 64 + lane];
            v += F_bmod[l * 3072 + n];
            if (n >= 2048) v = v * F_gpost[l * D + n - 2048];
            else if (n >= 1024) v = F_gpre[l * D + n - 1024] * (1.f + v);
            WSP(float, WS_MODV)[((size_t)l * 5 + q) * 3072 + n] = v; }
        flag_signal((unsigned*)(F.ws + WS_CTL) + 12288);
        __syncthreads();
    }
    LAS float* trig = (LAS float*)(F.lds + 8 * 16384);
    if (F.tid < 64) { float sn, cs; sincospif((float)F.tid * (1.f / 32.f), &sn, &cs); trig[F.tid] = cs; trig[64 + F.tid] = sn; }
    __syncthreads();
    for (int it = NGW - 1 - gw; it < 512; it += NGW) {
        const int l = it >> 8, row = it & 255, g = row >> 6, d = row & 63;
        const float* wf = F_wfour + (size_t)l * 65536 + (size_t)(g * 64) * 256 + lane;
        float ac[4] = {0.f, 0.f, 0.f, 0.f}, as[4] = {0.f, 0.f, 0.f, 0.f};
#pragma unroll 8
        for (int dp = 0; dp < 64; ++dp) { const int ix = (d * dp) & 63; const float cs = trig[ix], sn = trig[64 + ix];
#pragma unroll
            for (int q = 0; q < 4; ++q) { const float wv = wf[dp * 256 + 64 * q]; ac[q] += cs * wv; as[q] += sn * wv; } }
        float* wc = WSP(float, WS_WCS) + ((size_t)(l * 2 + 0) * 256 + row) * 256;
        float* wsn = WSP(float, WS_WCS) + ((size_t)(l * 2 + 1) * 256 + row) * 256;
#pragma unroll
        for (int q = 0; q < 4; ++q) { wc[lane + 64 * q] = ac[q] * 0.125f; wsn[lane + 64 * q] = as[q] * 0.125f; }
    }
    if (F.bid >= F.G - 64) flag_signal((unsigned*)(F.ws + WS_CTL) + 12352);
    {
        constexpr int NT = 2 * 4128;
        const int nw96 = 96 * 8, NSPLIT = NT - 2 * nw96;
        const bool small = F.bid < 96;
        const int stride = small ? nw96 : NGW - nw96, itend = small ? NT : NSPLIT;
        TDesc cur, nxt; float va[32], vb[32];
        int it = small ? NSPLIT + gw : gw - nw96;
        if (it < itend) { t_desc(F, it, cur); t_load(cur, lane, va); }
        while (it < itend) {
            const int itn = it + stride;
            if (itn < itend) { t_desc(F, itn, nxt); t_load(nxt, lane, vb); }
            t_store(cur, lane, va, scr);
            cur = nxt; it = itn;
#pragma unroll
            for (int i = 0; i < 32; ++i) va[i] = vb[i];
        }
    }
    const int gt = F.bid * 512 + F.tid, NGT = F.G * 512;
    for (int i = gt; i < 128 * 128; i += NGT) {
        const int n = i >> 7, k = i & 127, rip = n >> 6, k1 = n & 63, ri = k >> 6, n1 = k & 63;
        float sn, cs; sincospif((float)((k1 * n1) & 63) * (1.f / 32.f), &sn, &cs);
        const float v = rip == 0 ? (ri == 0 ? cs : -sn) : (ri == 0 ? -sn : -cs);
        WSP(bf16, WS_D1T)[i] = (bf16)f2bf(v);
    }
    for (int i = gt; i < 64 * 128; i += NGT) {
        const int k2 = i >> 7, k = i & 127, ri = k >> 6, n2 = k & 63;
        float sn, cs; sincospif((float)((k2 * n2) & 63) * (1.f / 32.f), &sn, &cs);
        WSP(bf16, WS_E2T)[i] = (bf16)f2bf((ri == 0 ? cs : sn) * (1.f / 64.f));
    }
    for (int i = gt; i < 64 * 64; i += NGT) {
        const int k1 = i >> 6, n2 = i & 63;
        float sn, cs; sincospif((float)(k1 * n2) * (1.f / 2048.f), &sn, &cs);
        WSP(float, WS_TW)[2 * i] = cs; WSP(float, WS_TW)[2 * i + 1] = sn;
    }
    for (int i = gt; i < 256 * 512; i += NGT) {
        const int k = i >> 9, kk = i & 511, ri = kk >> 8, n = kk & 255;
        float sn, cs; sincospif((float)((k * n) & 255) * (1.f / 128.f), &sn, &cs);
        WSP(bf16, WS_DCTX)[i] = (bf16)f2bf((ri == 0 ? cs : -sn) * (1.f / 16.f));
    }
}

struct Row16 { float v[16]; };
__device__ __forceinline__ void ld_row_f32(const float* p, int lane, Row16& r) {
#pragma unroll
    for (int j = 0; j < 2; ++j) { const f32x4 a = *(const f32x4*)(p + 512 * j + 8 * lane), b = *(const f32x4*)(p + 512 * j + 8 * lane + 4);
        r.v[8 * j + 0] = a.x; r.v[8 * j + 1] = a.y; r.v[8 * j + 2] = a.z; r.v[8 * j + 3] = a.w; r.v[8 * j + 4] = b.x; r.v[8 * j + 5] = b.y; r.v[8 * j + 6] = b.z; r.v[8 * j + 7] = b.w; }
}
__device__ __forceinline__ void st_row_f32(float* p, int lane, const Row16& r) {
#pragma unroll
    for (int j = 0; j < 2; ++j) { *(f32x4*)(p + 512 * j + 8 * lane) = (f32x4){r.v[8 * j], r.v[8 * j + 1], r.v[8 * j + 2], r.v[8 * j + 3]};
        *(f32x4*)(p + 512 * j + 8 * lane + 4) = (f32x4){r.v[8 * j + 4], r.v[8 * j + 5], r.v[8 * j + 6], r.v[8 * j + 7]}; }
}
__device__ __forceinline__ void ld_row_bf16(const bf16* p, int lane, Row16& r) {
#pragma unroll
    for (int j = 0; j < 2; ++j) { const u32x4 a = *(const u32x4*)(p + 512 * j + 8 * lane);
        r.v[8 * j + 0] = bflo(a.x); r.v[8 * j + 1] = bfhi(a.x); r.v[8 * j + 2] = bflo(a.y); r.v[8 * j + 3] = bfhi(a.y); r.v[8 * j + 4] = bflo(a.z); r.v[8 * j + 5] = bfhi(a.z); r.v[8 * j + 6] = bflo(a.w); r.v[8 * j + 7] = bfhi(a.w); }
}
__device__ __forceinline__ void st_row_bf16(bf16* p, int lane, const Row16& r) {
#pragma unroll
    for (int j = 0; j < 2; ++j) { u32x4 o; o.x = cvt_pk_bf16(r.v[8 * j], r.v[8 * j + 1]); o.y = cvt_pk_bf16(r.v[8 * j + 2], r.v[8 * j + 3]); o.z = cvt_pk_bf16(r.v[8 * j + 4], r.v[8 * j + 5]); o.w = cvt_pk_bf16(r.v[8 * j + 6], r.v[8 * j + 7]);
        *(u32x4*)(p + 512 * j + 8 * lane) = o; }
}
struct RowVecs { Row16 g2, g1, sh; };
__device__ __forceinline__ void row_apply(Frame& F, int mode, int row, bool lat, Row16& xv, const Row16& yv, float sp, const RowVecs& V) {
    const int lane = F.lane;
    if (mode != 0) {
        const float rs = __builtin_amdgcn_rsqf(wave_sum(sp) * (1.f / D) + EPS);
#pragma unroll
        for (int i = 0; i < 16; ++i) xv.v[i] += V.g2.v[i] * yv.v[i] * rs;
#ifdef DIAG_THR
        if (mode == 2) { const unsigned cntb = *(const unsigned*)(F.ws + WS_CTL + 768 * 1024);
            const float sc_ = 1.f + fminf((float)cntb, 1000.f) * 0.0005f;
#pragma unroll
            for (int i = 0; i < 16; ++i) xv.v[i] *= sc_; }
#endif
#ifdef TS_A
        if (mode == 2) { const unsigned long long* ts = (const unsigned long long*)(F.ws + WS_CTL + 512 * 1024);
#ifdef TS_ARGMAX
            float dA = (float)((ts[TS_B] >> TS_ARGMAX) & 15ull) * 10.f;
#else
            float dA = (float)(ts[TS_B] - ts[TS_A]) * 0.01f;
#endif
            dA = fminf(dA, (float)TS_CLAMP);
#pragma unroll
            for (int i = 0; i < 16; ++i) xv.v[i] *= (1.f + dA * (1.f / (float)TS_DIV)); }
#endif
        st_row_f32(F.out + (size_t)row * D, lane, xv);
    }
    if (mode != 2) {
        float s2 = 0.f;
#pragma unroll
        for (int i = 0; i < 16; ++i) s2 += xv.v[i] * xv.v[i];
        const float rs = __builtin_amdgcn_rsqf(wave_sum(s2) * (1.f / D) + EPS);
#pragma unroll
        for (int i = 0; i < 16; ++i) xv.v[i] = xv.v[i] * rs * V.g1.v[i] + V.sh.v[i];
        st_row_bf16(WSP(bf16, WS_XN) + (size_t)row * D, lane, xv);
    }
    (void)lat;
}
__device__ __forceinline__ void row_run(Frame& F, int mode, int b, int first, int stride, int nper) {
    const int lane = F.lane;
    const bf16* Y = WSP(bf16, WS_Y); const float* SSQ = WSP(float, WS_SSQ);
    const float* xsrc = mode == 2 ? F.out : F_x;
    RowVecs V;
#pragma unroll
    for (int i = 0; i < 16; ++i) { V.g2.v[i] = 0.f; V.g1.v[i] = 0.f; V.sh.v[i] = 0.f; }
    if (mode != 0) ld_row_f32(WSP(float, WS_MODV) + ((size_t)(mode - 1) * 5 + b) * 3072 + 2048, lane, V.g2);
    if (mode != 2) { ld_row_f32(WSP(float, WS_MODV) + ((size_t)mode * 5 + b) * 3072 + 1024, lane, V.g1); ld_row_f32(WSP(float, WS_MODV) + ((size_t)mode * 5 + b) * 3072, lane, V.sh); }
    Row16 xv, yv; float sp = 0.f;
#pragma unroll
    for (int i = 0; i < 16; ++i) yv.v[i] = 0.f;
    int row = first;
    ld_row_f32(xsrc + (size_t)row * D, lane, xv);
    if (mode != 0) { ld_row_bf16(Y + (size_t)row * D, lane, yv); sp = lane < 16 ? SSQ[(size_t)row * 16 + lane] : 0.f; }
    for (int i = 0; i < nper; ++i) {
        const int nrow = row + stride; Row16 nx, ny; float nsp = 0.f;
#pragma unroll
        for (int e = 0; e < 16; ++e) { nx.v[e] = 0.f; ny.v[e] = 0.f; }
        if (i + 1 < nper) { ld_row_f32(xsrc + (size_t)nrow * D, lane, nx); if (mode != 0) { ld_row_bf16(Y + (size_t)nrow * D, lane, ny); nsp = lane < 16 ? SSQ[(size_t)nrow * 16 + lane] : 0.f; } }
        row_apply(F, mode, row, true, xv, yv, sp, V);
        xv = nx; yv = ny; sp = nsp; row = nrow;
    }
}
__device__ __forceinline__ void row_phase(Frame& F, int mode) {
    const int gw = F.bid * 8 + F.wave, NGW = F.G * 8, lane = F.lane;
    const int QW = NGW / 4, b = gw / QW, li = gw % QW, nper = SEQ / QW;
    row_run(F, mode, b, b * SEQ + li, QW, nper);
    if (mode == 0 && gw < MC) {
        RowVecs V; Row16 xv, yv;
#pragma unroll
        for (int i = 0; i < 16; ++i) { V.g2.v[i] = 0.f; yv.v[i] = 0.f; }
        ld_row_f32(WSP(float, WS_MODV) + ((size_t)0 * 5 + 4) * 3072 + 1024, lane, V.g1); ld_row_f32(WSP(float, WS_MODV) + ((size_t)0 * 5 + 4) * 3072, lane, V.sh);
        ld_row_f32(F_ctx + (size_t)gw * D, lane, xv);
        row_apply(F, 0, ML + gw, false, xv, yv, 0.f, V);
    }
}
__device__ __forceinline__ void fold_phase(Frame& F) {
    LAS float* sW = (LAS float*)F.lds;
    LAS float* sA = (LAS float*)(F.lds + 65536) + F.wave * 2048;
    const int lane = F.lane, tid = F.tid;
    for (int id = F.bid; id < 256; id += F.G) {
        const int l = id >> 7, cs = (id >> 6) & 1, jq = (id >> 4) & 3, kg = id & 15, kb = kg * 8 + F.wave;
        const float* wcs = WSP(float, WS_WCS) + (size_t)(l * 2 + cs) * 65536 + 64 * jq;
        const float* wi = F_win + (size_t)l * D * INW + (size_t)(kb * 8) * INW + OUF;
        f32x4 pw[8], pa[8];
#pragma unroll
        for (int i = 0; i < 8; ++i) { const int idx = tid + 512 * i; pw[i] = *(const f32x4*)(wcs + (size_t)(idx >> 4) * 256 + 4 * (idx & 15)); }
#pragma unroll
        for (int i = 0; i < 8; ++i) pa[i] = *(const f32x4*)(wi + (size_t)i * INW + 4 * lane);
#pragma unroll
        for (int i = 0; i < 8; ++i) { const int idx = tid + 512 * i; *(LAS f32x4*)(sW + (idx >> 4) * 64 + 4 * (idx & 15)) = pw[i]; }
#pragma unroll
        for (int e = 0; e < 4; ++e) {
            *(LAS f32x4*)(sA + (4 * lane + e) * 8) = (f32x4){pa[0][e], pa[1][e], pa[2][e], pa[3][e]};
            *(LAS f32x4*)(sA + (4 * lane + e) * 8 + 4) = (f32x4){pa[4][e], pa[5][e], pa[6][e], pa[7][e]}; }
        __syncthreads();
        float a[8] = {0.f, 0.f, 0.f, 0.f, 0.f, 0.f, 0.f, 0.f};
#pragma unroll 8
        for (int m = 0; m < 256; ++m) { const float w = sW[m * 64 + lane]; const f32x4 x0 = *(const LAS f32x4*)(sA + m * 8), x1 = *(const LAS f32x4*)(sA + m * 8 + 4);
            a[0] += x0[0] * w; a[1] += x0[1] * w; a[2] += x0[2] * w; a[3] += x0[3] * w; a[4] += x1[0] * w; a[5] += x1[1] * w; a[6] += x1[2] * w; a[7] += x1[3] * w; }
        u32x4 o; o.x = cvt_pk_bf16(a[0], a[1]); o.y = cvt_pk_bf16(a[2], a[3]); o.z = cvt_pk_bf16(a[4], a[5]); o.w = cvt_pk_bf16(a[6], a[7]);
        *(u32x4*)(WSP(bf16, WS_BTIN) + (size_t)l * NIN * D + (size_t)(2048 + cs * 256 + 64 * jq + lane) * D + kb * 8) = o;
        __syncthreads();
    }
}

struct SchedA {
    int G, c, layer;
    __device__ __forceinline__ bool next(int i, Unit& u) const {
        const int L = i * G + c; const int nlat = 64 * 26, ntot = nlat + (layer == 0 ? 104 : 0);
        if (L >= ntot) return false;
        if (L < nlat) pg8::tile_of(L, 64, 26, u.pm, u.pn);
        else { const int j = L - nlat; u.pm = 64 + j / 26; u.pn = j % 26; }
        u.k0 = 0; u.nt = 16; u.tag = 0; return true;
    }
};
struct SchedV {
    int idx, nv;
    __device__ __forceinline__ bool next(int i, Unit& u) const {
        if (i > 0 || idx < 0 || idx >= nv) return false;
        u.pm = idx >> 1; u.pn = 4 + (idx & 1); u.k0 = 0; u.nt = 16; u.tag = 0; return true;
    }
};
struct SchedTile {
    int pm, pn, chain;
    __device__ __forceinline__ bool next(int i, Unit& u) const {
        if (i >= (chain ? 3 : 1)) return false;
        u.pm = pm; u.pn = pn;
        if (chain) { u.k0 = i == 0 ? 0 : (i == 1 ? 512 : 768); u.nt = i == 0 ? 8 : 4; u.tag = i; u.amode = (i == 1 && pm < 64) ? 1 : 0; } else { u.k0 = 0; u.nt = 16; u.tag = 0; u.amode = 0; }
        return true;
    }
};
struct SchedC1 {
    int G, c, ntiles;
    __device__ __forceinline__ bool next(int i, Unit& u) const {
        const int T = (i / 3) * G + c, seg = i % 3;
        if (T >= ntiles) return false;
        if (T < 256) pg8::tile_of(T, 64, 4, u.pm, u.pn); else { u.pm = 64 + ((T - 256) >> 2); u.pn = (T - 256) & 3; }
        u.k0 = seg == 0 ? 0 : (seg == 1 ? 512 : 768); u.nt = seg == 0 ? 8 : 4; u.tag = seg; return true;
    }
};
struct SchedC2 {
    int G, c, ntiles;
    __device__ __forceinline__ bool next(int i, Unit& u) const {
        const int T = i * G + c;
        if (T >= ntiles) return false;
        if (T < 256) pg8::tile_of(T, 64, 4, u.pm, u.pn); else { u.pm = 64 + ((T - 256) >> 2); u.pn = (T - 256) & 3; }
        u.k0 = 0; u.nt = 16; u.tag = 0; return true;
    }
};
struct SchedFc {
    int b;
    __device__ __forceinline__ bool next(int i, Unit& u) const { if (i > 0) return false; u.pm = 0; u.pn = b; u.k0 = 0; u.nt = 8; u.tag = 0; return true; }
};

struct EpiIn {
    unsigned char* wsb;
    __device__ __forceinline__ bool operator()(AccRef acc, const Unit& u, int wr, int wc, int fr, int fq) const {
        bf16* const Q = (bf16*)(wsb + WS_Q); bf16* const K = (bf16*)(wsb + WS_K); bf16* const VTL = (bf16*)(wsb + WS_VTL); bf16* const VTC = (bf16*)(wsb + WS_VTC); bf16* const GA = (bf16*)(wsb + WS_GA);
        bf16* const UFL = (bf16*)(wsb + WS_UFL); bf16* const ZT = (bf16*)(wsb + WS_ZT); bf16* const GF = (bf16*)(wsb + WS_GF); bf16* const GLU = (bf16*)(wsb + WS_GLU); bf16* const GC = (bf16*)(wsb + WS_GC); unsigned char* const S = wsb + WS_S;
        const int pn = u.pn, pm = u.pm;
        const int rl = wr * 64 + fr;
        const size_t row0 = (size_t)pm * 256 + rl;
        const int cl = wc * 32 + 8 * fq;
        if (pn == 10 && pm < 64) {
            const int b = pm >> 4;
#pragma unroll
            for (int ai = 0; ai < 2; ++ai)
#pragma unroll
                for (int m = 0; m < 4; ++m) { const int ntok = (pm & 15) * 256 + ai * 128 + m * 16 + rl;
#pragma unroll
                    for (int bj = 0; bj < 2; ++bj)
#pragma unroll
                        for (int n = 0; n < 2; ++n) { const int cb4 = (bj * 128 + cl) / 4 + n; f32x4 v = acc[ai][bj][m][n];
#pragma unroll
                            for (int e = 0; e < 4; ++e) v[e] = fast_silu(v[e]);
                            *(u32x2*)(GF + ((size_t)(b * 64 + cb4) * 4096 + ntok) * 4) = (u32x2){cvt_pk_bf16(v[0], v[1]), cvt_pk_bf16(v[2], v[3])}; } }
        } else if (pn < 4 || (pn >= 6 && pn < 8) || pn == 10 || pn == 13) {
            bf16* base; int ldc, col0; int act;
            if (pn < 2) { base = Q; ldc = 512; col0 = pn * 256; act = 1; }
            else if (pn < 4) { base = K; ldc = 512; col0 = (pn - 2) * 256; act = 0; }
            else if (pn < 8) { base = GA; ldc = 512; col0 = (pn - 6) * 256; act = 2; }
            else if (pn == 10) { base = GF; ldc = 256; col0 = 0; act = 2; }
            else { base = GC; ldc = 256; col0 = 0; act = 2; }
#pragma unroll
            for (int ai = 0; ai < 2; ++ai)
#pragma unroll
                for (int m = 0; m < 4; ++m) { bf16* rp = base + (row0 + ai * 128 + m * 16) * ldc + col0 + cl;
#pragma unroll
                    for (int bj = 0; bj < 2; ++bj) { f32x4 v0 = acc[ai][bj][m][0], v1 = acc[ai][bj][m][1];
                        if (act == 1) { v0 = v0 * QSCALE; v1 = v1 * QSCALE; }
                        if (act == 2) {
#pragma unroll
                            for (int e = 0; e < 4; ++e) { v0[e] = fast_silu(v0[e]); v1[e] = fast_silu(v1[e]); } }
                        u32x4 w; w.x = cvt_pk_bf16(v0[0], v0[1]); w.y = cvt_pk_bf16(v0[2], v0[3]); w.z = cvt_pk_bf16(v1[0], v1[1]); w.w = cvt_pk_bf16(v1[2], v1[3]);
                        *(u32x4*)(rp + bj * 128) = w; } }
        } else if (pn < 6) {
#pragma unroll
            for (int ai = 0; ai < 2; ++ai)
#pragma unroll
                for (int m = 0; m < 4; ++m) { const int t = ai * 128 + m * 16 + rl;
                    bf16* tb; size_t ts;
                    if (pm < 64) { tb = VTL + (size_t)(pm >> 4) * 8 * 64 * 4096 + (pm & 15) * 256 + t; ts = 4096; } else { tb = VTC + (size_t)(pm - 64) * 8 * 64 * 256 + t; ts = 256; }
#pragma unroll
                    for (int bj = 0; bj < 2; ++bj)
#pragma unroll
                        for (int n = 0; n < 2; ++n)
#pragma unroll
                            for (int e = 0; e < 4; ++e) { const int vcol = (pn - 4) * 256 + bj * 128 + cl + 4 * n + e;
                                tb[(size_t)vcol * ts] = (bf16)f2bf(acc[ai][bj][m][n][e]); } }
        } else if (pn < 10) {
            const int ri = pn - 8;
#pragma unroll
            for (int ai = 0; ai < 2; ++ai)
#pragma unroll
                for (int m = 0; m < 4; ++m) { const int t = ai * 128 + m * 16 + rl;
                    if (pm < 64) { const int b = pm >> 4, ntok = (pm & 15) * 256 + t;
#pragma unroll
                        for (int bj = 0; bj < 2; ++bj)
#pragma unroll
                            for (int n = 0; n < 2; ++n) { const int cb4 = (bj * 128 + cl) / 4 + n; const f32x4 v = acc[ai][bj][m][n];
                                u32x2 w; w.x = cvt_pk_bf16(v[0], v[1]); w.y = cvt_pk_bf16(v[2], v[3]);
                                *(u32x2*)(UFL + ((size_t)((b * 2 + ri) * 64 + cb4) * 4096 + ntok) * 4) = w; }
                    } else { const int b = pm - 64;
#pragma unroll
                        for (int bj = 0; bj < 2; ++bj)
#pragma unroll
                            for (int n = 0; n < 2; ++n)
#pragma unroll
                                for (int e = 0; e < 4; ++e) { const int ch = bj * 128 + cl + 4 * n + e;
                                    ZT[((size_t)(b * 256 + ch) * 2 + ri) * 256 + t] = (bf16)f2bf(acc[ai][bj][m][n][e]); } } }
        } else if (pn < 13) {
            const int col0 = (pn - 11) * 128 + cl;
#pragma unroll
            for (int ai = 0; ai < 2; ++ai)
#pragma unroll
                for (int m = 0; m < 4; ++m) { f32x4 a0 = acc[ai][0][m][0], a1 = acc[ai][0][m][1]; const f32x4 b0 = acc[ai][1][m][0], b1 = acc[ai][1][m][1];
#pragma unroll
                    for (int e = 0; e < 4; ++e) { a0[e] *= fast_sigmoid(b0[e]); a1[e] *= fast_sigmoid(b1[e]); }
                    u32x4 w; w.x = cvt_pk_bf16(a0[0], a0[1]); w.y = cvt_pk_bf16(a0[2], a0[3]); w.z = cvt_pk_bf16(a1[0], a1[1]); w.w = cvt_pk_bf16(a1[2], a1[3]);
                    *(u32x4*)(GLU + (row0 + ai * 128 + m * 16) * 256 + col0) = w; }
        } else {
            const int g = (pn - 14) >> 2, pl = (pn - 14) & 3;
            unsigned char* sb = S + (size_t)g * MT * 1024 + pl * 256 + 64 * wc + 16 * fq;
#pragma unroll
            for (int ai = 0; ai < 2; ++ai)
#pragma unroll
                for (int m = 0; m < 4; ++m) { unsigned w[4];
#pragma unroll
                    for (int bj = 0; bj < 2; ++bj)
#pragma unroll
                        for (int n = 0; n < 2; ++n) { const f32x4 v = acc[ai][bj][m][n]; unsigned p = 0;
#pragma unroll
                            for (int e = 0; e < 4; ++e) { const unsigned q = (unsigned)fmaxf(fast_sigmoid(v[e]) * 255.f + 0.5f, 1.f); p |= q << (8 * e); }
                            w[bj * 2 + n] = p; }
                    *(u32x4*)(sb + (row0 + ai * 128 + m * 16) * 1024) = (u32x4){w[0], w[1], w[2], w[3]}; }
        }
        return false;
    }
};
struct EpiV {
    unsigned char* wsb;
    __device__ __forceinline__ bool operator()(AccRef acc, const Unit& u, int wr, int wc, int fr, int fq) const {
        const int pm = u.pm, pn = u.pn;
        bf16* tb; unsigned ts;
        if (pm < 64) { tb = (bf16*)(wsb + WS_VTL) + (size_t)(pm >> 4) * 8 * 64 * 4096 + (pm & 15) * 256; ts = 4096; } else { tb = (bf16*)(wsb + WS_VTC) + (size_t)(pm - 64) * 8 * 64 * 256; ts = 256; }
#pragma unroll
        for (int bj = 0; bj < 2; ++bj)
#pragma unroll
            for (int n = 0; n < 2; ++n) { const int vcol = (pn - 4) * 256 + bj * 128 + wc * 32 + pg8::perm32(16 * n + fr);
                bf16* cp = tb + (size_t)vcol * ts + wr * 64 + 4 * fq;
#pragma unroll
                for (int ai = 0; ai < 2; ++ai)
#pragma unroll
                    for (int m = 0; m < 4; ++m) { const f32x4 v = acc[ai][bj][m][n];
                        *(u32x2*)(cp + ai * 128 + m * 16) = (u32x2){cvt_pk_bf16(v[0], v[1]), cvt_pk_bf16(v[2], v[3])}; } }
        return false;
    }
};
struct EpiC1 {
    bf16* MG; const unsigned char* S;
    __device__ __forceinline__ bool operator()(AccRef acc, const Unit& u, int wr, int wc, int fr, int fq) const {
        const int seg = u.tag; const bool mid = seg < 2;
        const unsigned row0 = (unsigned)(u.pm * 256 + wr * 64 + fr);
        const unsigned char* sb = S + (size_t)seg * MT * 1024 + u.pn * 256 + 64 * wc + 16 * fq;
        const unsigned char* sn = mid ? sb + (size_t)MT * 1024 : sb;
#pragma unroll
        for (int ai = 0; ai < 2; ++ai) {
            u32x4 sv[4], nv[4];
#pragma unroll
            for (int m = 0; m < 4; ++m) { const unsigned off = (row0 + (unsigned)(ai * 128 + m * 16)) * 1024u; sv[m] = *(const u32x4*)(sb + off); nv[m] = *(const u32x4*)(sn + off); }
#pragma unroll
            for (int m = 0; m < 4; ++m) { const u32x4 s4 = sv[m], n4 = mid ? nv[m] : (u32x4){~0u, ~0u, ~0u, ~0u};
#pragma unroll
                for (int bj = 0; bj < 2; ++bj) {
                    const unsigned g0 = bj == 0 ? s4.x : s4.z, g1 = bj == 0 ? s4.y : s4.w, h0 = bj == 0 ? n4.x : n4.z, h1 = bj == 0 ? n4.y : n4.w;
#pragma unroll
                    for (int e = 0; e < 4; ++e) {
                        const float q0 = (float)((g0 >> (8 * e)) & 255u), q1 = (float)((g1 >> (8 * e)) & 255u);
                        const float d0 = (float)((h0 >> (8 * e)) & 255u), d1 = (float)((h1 >> (8 * e)) & 255u);
                        acc[ai][bj][m][0][e] *= q0 * __builtin_amdgcn_rcpf(d0); acc[ai][bj][m][1][e] *= q1 * __builtin_amdgcn_rcpf(d1); } } }
            asm volatile("" ::: "memory"); }
        if (!mid) {
            bf16* mb = MG + u.pn * 256 + wc * 32 + 8 * fq;
#pragma unroll
            for (int ai = 0; ai < 2; ++ai)
#pragma unroll
                for (int m = 0; m < 4; ++m) { const unsigned off = (row0 + (unsigned)(ai * 128 + m * 16)) * 1024u;
#pragma unroll
                    for (int bj = 0; bj < 2; ++bj) { const f32x4 v0 = acc[ai][bj][m][0], v1 = acc[ai][bj][m][1];
                        u32x4 w; w.x = cvt_pk_bf16(v0[0], v0[1]); w.y = cvt_pk_bf16(v0[2], v0[3]); w.z = cvt_pk_bf16(v1[0], v1[1]); w.w = cvt_pk_bf16(v1[2], v1[3]);
                        *(u32x4*)(mb + (off + (unsigned)(bj * 128))) = w; } }
        }
        return mid;
    }
};
struct EpiC2 {
    bf16* Y; float* SSQ;
    __device__ __forceinline__ bool operator()(AccRef acc, const Unit& u, int wr, int wc, int fr, int fq) const {
        const size_t row0 = (size_t)u.pm * 256 + wr * 64 + fr;
        bf16* yb = Y + u.pn * 256 + wc * 32 + 8 * fq;
#pragma unroll
        for (int ai = 0; ai < 2; ++ai)
#pragma unroll
            for (int m = 0; m < 4; ++m) { const size_t row = row0 + ai * 128 + m * 16; float s = 0.f;
#pragma unroll
                for (int bj = 0; bj < 2; ++bj) { const f32x4 v0 = acc[ai][bj][m][0], v1 = acc[ai][bj][m][1];
                    s += (v0[0] * v0[0] + v0[1] * v0[1]) + (v0[2] * v0[2] + v0[3] * v0[3]) + (v1[0] * v1[0] + v1[1] * v1[1]) + (v1[2] * v1[2] + v1[3] * v1[3]);
                    u32x4 w; w.x = cvt_pk_bf16(v0[0], v0[1]); w.y = cvt_pk_bf16(v0[2], v0[3]); w.z = cvt_pk_bf16(v1[0], v1[1]); w.w = cvt_pk_bf16(v1[2], v1[3]);
                    *(u32x4*)(yb + row * 1024 + bj * 128) = w; }
                s += __shfl_xor(s, 16); s += __shfl_xor(s, 32);
                if (fq == 0) SSQ[row * 16 + u.pn * 4 + wc] = s; }
        return false;
    }
};
struct EpiFc {
    bf16* ACAT; const bf16* GF;
    __device__ __forceinline__ bool operator()(AccRef acc, const Unit& u, int wr, int wc, int fr, int fq) const {
        const size_t row0 = (size_t)ML + u.pn * 256 + wr * 64 + fr; const int cl = wc * 32 + 8 * fq;
#pragma unroll
        for (int ai = 0; ai < 2; ++ai) {
            u32x4 gqv[4][2];
#pragma unroll
            for (int m = 0; m < 4; ++m)
#pragma unroll
                for (int bj = 0; bj < 2; ++bj) gqv[m][bj] = *(const u32x4*)(GF + (row0 + ai * 128 + m * 16) * 256 + bj * 128 + cl);
            asm volatile("" ::: "memory");
#pragma unroll
            for (int m = 0; m < 4; ++m) { const size_t row = row0 + ai * 128 + m * 16;
#pragma unroll
                for (int bj = 0; bj < 2; ++bj) { f32x4 v0 = acc[ai][bj][m][0], v1 = acc[ai][bj][m][1];
                    const u32x4 gq = gqv[m][bj];
                    v0[0] *= bflo(gq.x); v0[1] *= bfhi(gq.x); v0[2] *= bflo(gq.y); v0[3] *= bfhi(gq.y); v1[0] *= bflo(gq.z); v1[1] *= bfhi(gq.z); v1[2] *= bflo(gq.w); v1[3] *= bfhi(gq.w);
                    u32x4 w; w.x = cvt_pk_bf16(v0[0], v0[1]); w.y = cvt_pk_bf16(v0[2], v0[3]); w.z = cvt_pk_bf16(v1[0], v1[1]); w.w = cvt_pk_bf16(v1[2], v1[3]);
                    *(u32x4*)(ACAT + row * 1024 + 512 + bj * 128 + cl) = w; } } }
        return false;
    }
};

constexpr int AT_KS = 72, AT_VS = 68;
constexpr int AT_KOFF = 0, AT_VOFF = 4 * 64 * AT_KS * 2, AT_BOFF = AT_VOFF + 4 * 64 * AT_VS * 2;
struct FourPre { u32x2 t4[4][4]; };
__device__ __forceinline__ void four_pre(Frame& F, int item, FourPre& P) {
    const int tid = F.tid, b = item >> 6, cb = item & 63;
    const bf16* UFL = WSP(bf16, WS_UFL);
#pragma unroll
    for (int q = 0; q < 4; ++q) { const int task = tid + 512 * q, n2 = task & 63, n1q = (task >> 6) & 15, ri = task >> 10;
        const bf16* src = UFL + ((size_t)((b * 2 + ri) * 64 + cb) * 4096 + (size_t)(256 * n1q + n2)) * 4;
#pragma unroll
        for (int i = 0; i < 4; ++i) P.t4[q][i] = *(const u32x2*)(src + (size_t)i * 64 * 4); }
}
struct AttnDesc { int b, h, R0, nwin, r, c0; size_t qbase; bool isctx; };
__device__ __forceinline__ AttnDesc attn_desc(Frame& F, int unit) {
    AttnDesc d; const int w = F.wave;
    d.isctx = unit >= 512; d.R0 = 0; d.nwin = 0; d.r = 0; d.c0 = 0;
    if (!d.isctx) { d.b = unit >> 7; d.h = (unit >> 4) & 7; const int rb = unit & 15; const int ra = 4 * rb;
        d.R0 = min(max(ra - 4, 0), 56); const int R1 = min(max(ra + 3 - 4, 0), 56) + 8; d.nwin = R1 - d.R0;
        d.r = ra + (w >> 1); d.c0 = 32 * (w & 1); d.qbase = (size_t)d.b * SEQ + d.r * 64 + d.c0; }
    else { const int j = unit - 512; d.b = j >> 3; d.h = j & 7; d.qbase = (size_t)ML + d.b * CTX + 32 * w; }
    return d;
}
struct AttnPre { bf16x8 qf[2][2]; u32x4 k0, v0, k1, v1; float bias; };
__device__ __forceinline__ void attn_pre(Frame& F, int unit, int layer, AttnPre& P) {
    const AttnDesc d = attn_desc(F, unit); const int tid = F.tid, fr = F.lane & 15, fq = F.lane >> 4, srow = tid >> 3, sch = tid & 7;
#pragma unroll
    for (int g = 0; g < 2; ++g)
#pragma unroll
        for (int ks = 0; ks < 2; ++ks) P.qf[g][ks] = *(const bf16x8*)(WSP(bf16, WS_Q) + (d.qbase + 16 * g + fr) * 512 + d.h * 64 + 32 * ks + 8 * fq);
    const bf16* vtl = WSP(bf16, WS_VTL) + ((size_t)(d.b * 8 + d.h) * 64 + srow) * 4096 + sch * 8;
    const bf16* vtc = WSP(bf16, WS_VTC) + ((size_t)(d.b * 8 + d.h) * 64 + srow) * 256 + sch * 8;
    const bf16* Kp = WSP(bf16, WS_K);
#pragma unroll
    for (int t = 0; t < 2; ++t) { size_t ktok; const bf16* vp;
        if (t < d.nwin) { ktok = (size_t)d.b * SEQ + (size_t)(d.R0 + t) * 64; vp = vtl + (d.R0 + t) * 64; } else { ktok = (size_t)ML + d.b * CTX + (t - d.nwin) * 64; vp = vtc + (t - d.nwin) * 64; }
        const u32x4 kk = *(const u32x4*)(Kp + (ktok + srow) * 512 + d.h * 64 + sch * 8), vv = *(const u32x4*)vp;
        if (t == 0) { P.k0 = kk; P.v0 = vv; } else { P.k1 = kk; P.v1 = vv; } }
    P.bias = (!d.isctx && tid < 465) ? F_rpb[((size_t)layer * NH + d.h) * 465 + tid] * LOG2E : 0.f;
}
template <bool FOURPF>
__device__ __forceinline__ void attn_unit(Frame& F, int unit, int layer, const AttnPre& P, int next_unit, AttnPre& NP, int four_next, FourPre& FP) {
    const int tid = F.tid, lane = F.lane, w = F.wave, fr = lane & 15, fq = lane >> 4;
    const bf16* Qp = WSP(bf16, WS_Q); const bf16* Kp = WSP(bf16, WS_K); const bf16* GA = WSP(bf16, WS_GA); bf16* ACAT = WSP(bf16, WS_XN);
    const AttnDesc dd = attn_desc(F, unit);
    const bool isctx = dd.isctx; const int b = dd.b, h = dd.h, R0 = dd.R0, nwin = dd.nwin, r = dd.r, c0 = dd.c0; const size_t qbase = dd.qbase;
    const int myrs = isctx ? 0 : (min(max(r - 4, 0), 56) - R0);
    const int nt = nwin + 4;
    LAS float* btab = (LAS float*)(F.lds + AT_BOFF);
    if (!isctx && tid < 465) btab[64 + tid] = P.bias;
    bf16x8 qf[2][2];
#pragma unroll
    for (int g = 0; g < 2; ++g)
#pragma unroll
        for (int ks = 0; ks < 2; ++ks) qf[g][ks] = P.qf[g][ks];
    const int srow = tid >> 3, sch = tid & 7;
    const bf16* vtl = WSP(bf16, WS_VTL) + ((size_t)(b * 8 + h) * 64 + srow) * 4096 + sch * 8;
    const bf16* vtc = WSP(bf16, WS_VTC) + ((size_t)(b * 8 + h) * 64 + srow) * 256 + sch * 8;
    u32x4 kA = P.k0, vA = P.v0, kB = P.k1, vB = P.v1;
#define AT_LOAD(t, kreg, vreg) do { const int _t = (t); size_t ktok; const bf16* vp; \
        if (_t < nwin) { ktok = (size_t)b * SEQ + (size_t)(R0 + _t) * 64; vp = vtl + (R0 + _t) * 64; } else { ktok = (size_t)ML + b * CTX + (_t - nwin) * 64; vp = vtc + (_t - nwin) * 64; } \
        kreg = *(const u32x4*)(Kp + (ktok + srow) * 512 + h * 64 + sch * 8); vreg = *(const u32x4*)vp; } while (0)
#define AT_WRITE(buf, kreg, vreg) do { *(LAS u32x4*)(F.lds + AT_KOFF + (buf) * 64 * AT_KS * 2 + (srow * AT_KS + sch * 8) * 2) = kreg; \
        LAS u32x2* _v = (LAS u32x2*)(F.lds + AT_VOFF + (buf) * 64 * AT_VS * 2 + (srow * AT_VS + sch * 8) * 2); _v[0] = (u32x2){vreg.x, vreg.y}; _v[1] = (u32x2){vreg.z, vreg.w}; } while (0)
    AT_WRITE(0, kA, vA); AT_WRITE(1, kB, vB);
    __syncthreads();
    f32x4 O[2][4];
#pragma unroll
    for (int g = 0; g < 2; ++g)
#pragma unroll
        for (int dt = 0; dt < 4; ++dt) O[g][dt] = (f32x4){0.f, 0.f, 0.f, 0.f};
    float lrun[2] = {0.f, 0.f};
    const unsigned koffl = (unsigned)((fr * AT_KS + 8 * fq) * 2), voffl = (unsigned)((fr * AT_VS + 4 * fq) * 2);
#define AT_VLOAD(vf, vad) do { _Pragma("unroll") for (int dt = 0; dt < 4; ++dt) { \
            const u32x2 v0 = *(const LAS u32x2*)(F.lds + (vad) + (16 * dt * AT_VS) * 2), v1 = *(const LAS u32x2*)(F.lds + (vad) + (16 * dt * AT_VS + 16) * 2); \
            (vf)[dt] = __builtin_bit_cast(bf16x8, (u32x4){v0.x, v0.y, v1.x, v1.y}); } } while (0)
#define AT_PVC(g, plo, phi, vf) do { \
        u32x4 pw; pw.x = cvt_pk_bf16((plo)[0], (plo)[1]); pw.y = cvt_pk_bf16((plo)[2], (plo)[3]); pw.z = cvt_pk_bf16((phi)[0], (phi)[1]); pw.w = cvt_pk_bf16((phi)[2], (phi)[3]); \
        const bf16x8 pf = __builtin_bit_cast(bf16x8, pw); \
        _Pragma("unroll") for (int dt = 0; dt < 4; ++dt) O[g][dt] = __builtin_amdgcn_mfma_f32_16x16x32_bf16((vf)[dt], pf, O[g][dt], 0, 0, 0); } while (0)
#define AT_COMPUTE(tt, bufi) do { const int t = (tt); const bool win = t < nwin; \
        if (!win || (t >= myrs && t < myrs + 8)) { \
            const unsigned kad = (unsigned)(AT_KOFF + (bufi) * 64 * AT_KS * 2) + koffl, vad = (unsigned)(AT_VOFF + (bufi) * 64 * AT_VS * 2) + voffl; \
            if (win) { const int dr = (R0 + t) - r + 7; \
                _Pragma("unroll") for (int g = 0; g < 2; ++g) { \
                    const int g0 = c0 + 16 * g, ksg = min(max(g0 - 8, 0), 32), qc = g0 + fr, cs = min(max(qc - 8, 0), 48); \
                    const LAS float* bp = btab + 64 + dr * 31 + 15 - qc + ksg + 4 * fq; const int lo = ksg + 4 * fq - cs; \
                    const unsigned kadg = kad + (unsigned)(ksg * AT_KS * 2), vadg = vad + (unsigned)(ksg * 2); \
                    bf16x8 ka[2][2], vf[4]; float bv[2][4]; \
                    _Pragma("unroll") for (int kt = 0; kt < 2; ++kt) _Pragma("unroll") for (int e = 0; e < 4; ++e) bv[kt][e] = bp[16 * kt + e]; \
                    _Pragma("unroll") for (int ks = 0; ks < 2; ++ks) _Pragma("unroll") for (int kt = 0; kt < 2; ++kt) ka[kt][ks] = *(const LAS bf16x8*)(F.lds + kadg + (16 * kt * AT_KS + 32 * ks) * 2); \
                    AT_VLOAD(vf, vadg); \
                    f32x4 s[2]; \
                    _Pragma("unroll") for (int kt = 0; kt < 2; ++kt) _Pragma("unroll") for (int e = 0; e < 4; ++e) s[kt][e] = ((unsigned)(16 * kt + e + lo) < 16u) ? bv[kt][e] : -1e30f; \
                    _Pragma("unroll") for (int ks = 0; ks < 2; ++ks) _Pragma("unroll") for (int kt = 0; kt < 2; ++kt) s[kt] = __builtin_amdgcn_mfma_f32_16x16x32_bf16(ka[kt][ks], qf[g][ks], s[kt], 0, 0, 0); \
                    float ls = 0.f; \
                    _Pragma("unroll") for (int kt = 0; kt < 2; ++kt) _Pragma("unroll") for (int e = 0; e < 4; ++e) { s[kt][e] = __builtin_amdgcn_exp2f(s[kt][e]); ls += s[kt][e]; } \
                    lrun[g] += ls; \
                    AT_PVC(g, s[0], s[1], vf); } \
                asm volatile("" ::: "memory"); \
            } else { \
                f32x4 sc[2][4]; \
                _Pragma("unroll") for (int g = 0; g < 2; ++g) _Pragma("unroll") for (int kt = 0; kt < 4; ++kt) sc[g][kt] = (f32x4){0.f, 0.f, 0.f, 0.f}; \
                bf16x8 ka[2][4], vfa[4], vfb[4]; \
                _Pragma("unroll") for (int ks = 0; ks < 2; ++ks) _Pragma("unroll") for (int kt = 0; kt < 4; ++kt) ka[ks][kt] = *(const LAS bf16x8*)(F.lds + kad + (16 * kt * AT_KS + 32 * ks) * 2); \
                AT_VLOAD(vfa, vad); AT_VLOAD(vfb, vad + 64u); \
                _Pragma("unroll") for (int ks = 0; ks < 2; ++ks) \
                    _Pragma("unroll") for (int g = 0; g < 2; ++g) _Pragma("unroll") for (int kt = 0; kt < 4; ++kt) sc[g][kt] = __builtin_amdgcn_mfma_f32_16x16x32_bf16(ka[ks][kt], qf[g][ks], sc[g][kt], 0, 0, 0); \
                _Pragma("unroll") for (int g = 0; g < 2; ++g) { \
                    float ls = 0.f; \
                    _Pragma("unroll") for (int kt = 0; kt < 4; ++kt) _Pragma("unroll") for (int e = 0; e < 4; ++e) { sc[g][kt][e] = __builtin_amdgcn_exp2f(sc[g][kt][e]); ls += sc[g][kt][e]; } \
                    lrun[g] += ls; \
                    AT_PVC(g, sc[g][0], sc[g][1], vfa); AT_PVC(g, sc[g][2], sc[g][3], vfb); } \
                asm volatile("" ::: "memory"); } } } while (0)
    for (int t0 = 0; t0 < nt; t0 += 2) {
        const int cb = (t0 & 2), nb = cb ^ 2;
        if (t0 + 2 < nt) AT_LOAD(t0 + 2, kA, vA);
        if (t0 + 3 < nt) AT_LOAD(t0 + 3, kB, vB);
        AT_COMPUTE(t0, cb);
        asm volatile("" ::: "memory");
        if (t0 + 1 < nt) AT_COMPUTE(t0 + 1, cb + 1);
        if (t0 + 2 < nt) AT_WRITE(nb, kA, vA);
        if (t0 + 3 < nt) AT_WRITE(nb + 1, kB, vB);
        __syncthreads();
    }
#undef AT_COMPUTE
#undef AT_PVC
#undef AT_VLOAD
#undef AT_LOAD
#undef AT_WRITE
    if constexpr (FOURPF) four_pre(F, four_next, FP); else attn_pre(F, next_unit, layer, NP);
    {
        u32x4 gqv[4];
#pragma unroll
        for (int i = 0; i < 4; ++i) { const int pidx = lane + 64 * i, q = pidx >> 3, c = pidx & 7; gqv[i] = *(const u32x4*)(GA + (qbase + q) * 512 + h * 64 + 8 * c); }
        LAS float* ow = (LAS float*)(F.lds + w * (32 * 68 * 4));
#pragma unroll
        for (int g = 0; g < 2; ++g) { float l = lrun[g]; l += __shfl_xor(l, 16); l += __shfl_xor(l, 32); const float inv = __builtin_amdgcn_rcpf(l);
#pragma unroll
            for (int dt = 0; dt < 4; ++dt) *(LAS f32x4*)(ow + (16 * g + fr) * 68 + 16 * dt + 4 * fq) = O[g][dt] * inv; }
#pragma unroll
        for (int i = 0; i < 4; ++i) { const int pidx = lane + 64 * i, q = pidx >> 3, c = pidx & 7;
            const f32x4 a = *(const LAS f32x4*)(ow + q * 68 + 8 * c), bq = *(const LAS f32x4*)(ow + q * 68 + 8 * c + 4);
            const u32x4 gq = gqv[i];
            u32x4 o; o.x = cvt_pk_bf16(a[0] * bflo(gq.x), a[1] * bfhi(gq.x)); o.y = cvt_pk_bf16(a[2] * bflo(gq.y), a[3] * bfhi(gq.y));
            o.z = cvt_pk_bf16(bq[0] * bflo(gq.z), bq[1] * bfhi(gq.z)); o.w = cvt_pk_bf16(bq[2] * bflo(gq.w), bq[3] * bfhi(gq.w));
            *(u32x4*)(ACAT + (qbase + q) * 1024 + h * 64 + 8 * c) = o; }
    }
    __syncthreads();
}

constexpr int FS = 144;
__device__ __forceinline__ void four_item(Frame& F, int item, const FourPre& FP) {
    const int tid = F.tid, lane = F.lane, w = F.wave, fr = lane & 15, fq = lane >> 4;
    const int b = item >> 6, cb = item & 63;
    LAS bf16* zT = (LAS bf16*)F.lds;
    LAS bf16* ZP = (LAS bf16*)(F.lds + 256 * FS * 2);
    const bf16* UFL = WSP(bf16, WS_UFL);
#pragma unroll
    for (int q = 0; q < 4; ++q) { const int task = tid + 512 * q, n2 = task & 63, n1q = (task >> 6) & 15, ri = task >> 10;
        u32x2 t4[4];
#pragma unroll
        for (int i = 0; i < 4; ++i) t4[i] = FP.t4[q][i];
#pragma unroll
        for (int ch = 0; ch < 4; ++ch) { unsigned e[4];
#pragma unroll
            for (int i = 0; i < 4; ++i) { const unsigned wd = (ch < 2) ? t4[i].x : t4[i].y; e[i] = (ch & 1) ? (wd >> 16) : (wd & 0xffffu); }
            *(LAS u32x2*)(zT + (ch * 64 + n2) * FS + ri * 64 + 4 * n1q) = (u32x2){e[0] | (e[1] << 16), e[2] | (e[3] << 16)}; } }
    const int t = w & 3, mh = w >> 2;
    const int k1 = 16 * t + fr, k2 = 16 * t + fr;
    bf16x8 bre[4], bim[4], bfv[4]; f32x4 tw0[8], tw1[8]; u32x2 gq[8];
    const bf16* GFb = WSP(bf16, WS_GF) + (size_t)(b * 64 + cb) * 4096 * 4;
    {
        const bf16* D1t = WSP(bf16, WS_D1T); const bf16* E2t = WSP(bf16, WS_E2T); const float* TW = WSP(float, WS_TW);
#pragma unroll
        for (int ks = 0; ks < 4; ++ks) { bre[ks] = *(const bf16x8*)(D1t + (16 * t + fr) * 128 + 32 * ks + 8 * fq); bim[ks] = *(const bf16x8*)(D1t + (16 * (t + 4) + fr) * 128 + 32 * ks + 8 * fq); }
#pragma unroll
        for (int mt = 0; mt < 8; ++mt) { const int M0 = 128 * mh + 16 * mt + 4 * fq, n2b = M0 & 63;
            tw0[mt] = *(const f32x4*)(TW + (size_t)(k1 * 64 + n2b) * 2); tw1[mt] = *(const f32x4*)(TW + (size_t)(k1 * 64 + n2b) * 2 + 4); }
#pragma unroll
        for (int ks = 0; ks < 4; ++ks) bfv[ks] = *(const bf16x8*)(E2t + (16 * t + fr) * 128 + 32 * ks + 8 * fq);
#pragma unroll
        for (int i = 0; i < 8; ++i) gq[i] = *(const u32x2*)(GFb + (size_t)(tid + 512 * i) * 4);
    }
    __syncthreads();
    {
#pragma unroll
        for (int mt = 0; mt < 8; ++mt) {
            const int M0 = 128 * mh + 16 * mt + 4 * fq, ch = M0 >> 6, n2b = M0 & 63;
            const f32x4 t0 = tw0[mt], t1 = tw1[mt];
            bf16x8 af[4];
#pragma unroll
            for (int ks = 0; ks < 4; ++ks) af[ks] = *(const LAS bf16x8*)(zT + (128 * mh + 16 * mt + fr) * FS + 32 * ks + 8 * fq);
            f32x4 zr = (f32x4){0.f, 0.f, 0.f, 0.f}, zi = (f32x4){0.f, 0.f, 0.f, 0.f};
#pragma unroll
            for (int ks = 0; ks < 4; ++ks) { zr = __builtin_amdgcn_mfma_f32_16x16x32_bf16(af[ks], bre[ks], zr, 0, 0, 0); zi = __builtin_amdgcn_mfma_f32_16x16x32_bf16(af[ks], bim[ks], zi, 0, 0, 0); }
            const float ct[4] = {t0.x, t0.z, t1.x, t1.z}, st[4] = {t0.y, t0.w, t1.y, t1.w};
            float pr[4], pi[4];
#pragma unroll
            for (int e = 0; e < 4; ++e) { pr[e] = zr[e] * ct[e] + zi[e] * st[e]; pi[e] = zi[e] * ct[e] - zr[e] * st[e]; }
            *(LAS u32x2*)(ZP + (k1 * 4 + ch) * FS + n2b) = (u32x2){cvt_pk_bf16(pr[0], pr[1]), cvt_pk_bf16(pr[2], pr[3])};
            *(LAS u32x2*)(ZP + (k1 * 4 + ch) * FS + 64 + n2b) = (u32x2){cvt_pk_bf16(pi[0], pi[1]), cvt_pk_bf16(pi[2], pi[3])};
        }
    }
    __syncthreads();
    LAS float* oimg = (LAS float*)F.lds;
    {
#pragma unroll
        for (int mt = 0; mt < 8; ++mt) {
            bf16x8 af[4];
#pragma unroll
            for (int ks = 0; ks < 4; ++ks) af[ks] = *(const LAS bf16x8*)(ZP + (128 * mh + 16 * mt + fr) * FS + 32 * ks + 8 * fq);
            f32x4 acc = (f32x4){0.f, 0.f, 0.f, 0.f};
#pragma unroll
            for (int ks = 0; ks < 4; ++ks) acc = __builtin_amdgcn_mfma_f32_16x16x32_bf16(af[ks], bfv[ks], acc, 0, 0, 0);
            const int k1o = (128 * mh + 16 * mt + 4 * fq) >> 2, n = k1o + 64 * k2;
            *(LAS f32x4*)(oimg + (n + (n >> 6)) * 4) = acc;
        }
    }
    __syncthreads();
    {
        bf16* AFb = WSP(bf16, WS_AFL) + (size_t)(b * 32 + (cb >> 1)) * 4096 * 8 + (cb & 1) * 4;
#pragma unroll
        for (int i = 0; i < 8; ++i) { const int n = tid + 512 * i; const f32x4 v = *(const LAS f32x4*)(oimg + (n + (n >> 6)) * 4);
            *(u32x2*)(AFb + (size_t)n * 8) = (u32x2){cvt_pk_bf16(v[0] * bflo(gq[i].x), v[1] * bfhi(gq[i].x)), cvt_pk_bf16(v[2] * bflo(gq[i].y), v[3] * bfhi(gq[i].y))}; }
    }
    __syncthreads();
}

constexpr int CV_GOFF = 0, CV_UOFF = 49152, CV_AS = 272, CV_US = 260;
__device__ __forceinline__ void conv_item(Frame& F, int item, int layer) {
#if defined(TS_MCONV)
#define CONV_MARK(k) do { if (TS_MCONV == (k) && item < 256 && layer == 1) TS_MARK(k); } while (0)
#else
#define CONV_MARK(k) do { } while (0)
#endif
    CONV_MARK(80);
    const int tid = F.tid, lane = F.lane, w = F.wave, fr = lane & 15, fq = lane >> 4;
    size_t row0; int lo, hi;
    if (item < 256) { const int b = item >> 6; row0 = (size_t)b * SEQ + (item & 63) * 64; lo = b * SEQ; hi = lo + SEQ; }
    else { const int j = item - 256, b = j >> 2; row0 = (size_t)ML + b * CTX + (j & 3) * 64; lo = ML + b * CTX; hi = lo + CTX; }
    const bf16* GLU = WSP(bf16, WS_GLU);
    LAS bf16* gt = (LAS bf16*)(F.lds + CV_GOFF);
    LAS float* U = (LAS float*)(F.lds + CV_UOFF);
    float wk[31]; float bias; bf16x8 bfv[8][2]; u32x4 gq[4];
    {
        u32x4 gv[6];
#pragma unroll
        for (int q = 0; q < 6; ++q) { const int i = tid + 512 * q, rr = i >> 5, ch = i & 31; const long grow = (long)row0 - 15 + rr;
            const bool ok = (i < 94 * 32) && grow >= lo && grow < hi;
            gv[q] = *(const u32x4*)(GLU + (size_t)(ok ? grow : (long)row0) * 256 + ch * 8);
            if (!ok) gv[q] = (u32x4){0u, 0u, 0u, 0u}; }
        {
            const int c = tid & 255;
#pragma unroll
            for (int t = 0; t < 31; ++t) wk[t] = F_cdw[((size_t)layer * 31 + t) * 256 + c];
            bias = F_cdb[layer * 256 + c];
            const bf16* GC = WSP(bf16, WS_GC);
#pragma unroll
            for (int i = 0; i < 4; ++i) { const int pidx = tid + 512 * i, tok = pidx >> 5, c8 = pidx & 31; gq[i] = *(const u32x4*)(GC + (row0 + tok) * 256 + 8 * c8); }
        }
#pragma unroll
        for (int q = 0; q < 6; ++q) { const int i = tid + 512 * q; if (i < 94 * 32) *(LAS u32x4*)(gt + (i >> 5) * 256 + (i & 31) * 8) = gv[q]; }
    }
    __syncthreads();
    CONV_MARK(81);
    {
        const int c = tid & 255, th = tid >> 8;
        typedef float f32x2 __attribute__((ext_vector_type(2)));
        f32x2 PE[16], PO[16];
#pragma unroll
        for (int i = 0; i < 16; ++i) { const int k0 = 2 * i, k1 = 2 * i + 1, k2 = 2 * i + 2;
            const float w0 = (k0 >= 1 && k0 <= 31) ? wk[31 - k0] : 0.f, w1 = (k1 >= 1 && k1 <= 31) ? wk[31 - k1] : 0.f, w2 = (k2 >= 1 && k2 <= 31) ? wk[31 - k2] : 0.f;
            PE[i] = (f32x2){w0, w1}; PO[i] = (f32x2){w1, w2}; }
#pragma unroll 1
        for (int q = 0; q < 4; ++q) {
            f32x2 a2[4];
#pragma unroll
            for (int pp = 0; pp < 4; ++pp) a2[pp] = (f32x2){bias, bias};
            const LAS bf16* gp = gt + (32 * th + 8 * q) * 256 + c; bf16 xs[38];
#pragma unroll
            for (int j = 0; j < 38; ++j) xs[j] = gp[j * 256];
            asm volatile("" ::: "memory");
#pragma unroll
            for (int j = 0; j < 38; ++j) { const float xv = bf2f(xs[j]); const f32x2 x2 = (f32x2){xv, xv};
#pragma unroll
                for (int pp = 0; pp < 4; ++pp) { const int Q = 31 - j + 2 * pp;
                    if (Q >= 0 && Q <= 31) a2[pp] += ((Q & 1) ? PO[(Q - 1) >> 1] : PE[Q >> 1]) * x2; } }
#pragma unroll
            for (int pp = 0; pp < 4; ++pp) { U[(32 * th + 8 * q + 2 * pp) * CV_US + c] = a2[pp].x; U[(32 * th + 8 * q + 2 * pp + 1) * CV_US + c] = a2[pp].y; }
        }
    }
    __syncthreads();
    CONV_MARK(82);
    {
        LAS bf16* At = (LAS bf16*)(F.lds + CV_GOFF);
        {   const bf16* Bt = WSP(bf16, WS_BTPW) + (size_t)layer * 65536;
#pragma unroll
            for (int ks = 0; ks < 8; ++ks)
#pragma unroll
                for (int n = 0; n < 2; ++n) bfv[ks][n] = *(const bf16x8*)(Bt + (size_t)(32 * w + 16 * n + fr) * 256 + 32 * ks + 8 * fq); }
        const f32x4 g = *(const f32x4*)(F_lng + layer * 256 + 4 * lane), bb = *(const f32x4*)(F_lnb + layer * 256 + 4 * lane);
        f32x4 v8[8]; float r8[8];
#pragma unroll
        for (int i = 0; i < 8; ++i) { v8[i] = *(const LAS f32x4*)(U + (8 * w + i) * CV_US + 4 * lane); r8[i] = (v8[i].x + v8[i].y) + (v8[i].z + v8[i].w); }
        wave_sum8(r8);
#pragma unroll
        for (int i = 0; i < 8; ++i) { v8[i] = v8[i] - r8[i] * (1.f / 256.f); r8[i] = (v8[i].x * v8[i].x + v8[i].y * v8[i].y) + (v8[i].z * v8[i].z + v8[i].w * v8[i].w); }
        wave_sum8(r8);
#pragma unroll
        for (int i = 0; i < 8; ++i) { const int tok = 8 * w + i;
            const float rs = __builtin_amdgcn_rsqf(r8[i] * (1.f / 256.f) + EPS);
            f32x4 y = v8[i] * rs * g + bb;
#pragma unroll
            for (int e = 0; e < 4; ++e) y[e] = fast_silu(y[e]);
            *(LAS u32x2*)(At + tok * CV_AS + 4 * lane) = (u32x2){cvt_pk_bf16(y[0], y[1]), cvt_pk_bf16(y[2], y[3])}; }
    }
    __syncthreads();
    CONV_MARK(83);
    {
        const LAS bf16* At = (const LAS bf16*)(F.lds + CV_GOFF);
        f32x4 acc[4][2];
#pragma unroll
        for (int m = 0; m < 4; ++m)
#pragma unroll
            for (int n = 0; n < 2; ++n) acc[m][n] = (f32x4){0.f, 0.f, 0.f, 0.f};
#pragma unroll
        for (int ks = 0; ks < 8; ++ks) {
            bf16x8 af[4];
#pragma unroll
            for (int m = 0; m < 4; ++m) af[m] = *(const LAS bf16x8*)(At + (16 * m + fr) * CV_AS + 32 * ks + 8 * fq);
#pragma unroll
            for (int m = 0; m < 4; ++m)
#pragma unroll
                for (int n = 0; n < 2; ++n) acc[m][n] = __builtin_amdgcn_mfma_f32_16x16x32_bf16(bfv[ks][n], af[m], acc[m][n], 0, 0, 0);
        }
#pragma unroll
        for (int m = 0; m < 4; ++m)
#pragma unroll
            for (int n = 0; n < 2; ++n) *(LAS f32x4*)(U + (16 * m + fr) * CV_US + 32 * w + 16 * n + 4 * fq) = acc[m][n];
    }
    __syncthreads();
    CONV_MARK(84);
    {
        bf16* ACAT = WSP(bf16, WS_XN);
#pragma unroll
        for (int i = 0; i < 4; ++i) { const int pidx = tid + 512 * i, tok = pidx >> 5, c8 = pidx & 31;
            const f32x4 a = *(const LAS f32x4*)(U + tok * CV_US + 8 * c8), bq = *(const LAS f32x4*)(U + tok * CV_US + 8 * c8 + 4); const u32x4 g4 = gq[i];
            u32x4 o; o.x = cvt_pk_bf16(a[0] * bflo(g4.x), a[1] * bfhi(g4.x)); o.y = cvt_pk_bf16(a[2] * bflo(g4.y), a[3] * bfhi(g4.y));
            o.z = cvt_pk_bf16(bq[0] * bflo(g4.z), bq[1] * bfhi(g4.z)); o.w = cvt_pk_bf16(bq[2] * bflo(g4.w), bq[3] * bfhi(g4.w));
            *(u32x4*)(ACAT + (row0 + tok) * 1024 + 768 + 8 * c8) = o; }
    }
    CONV_MARK(85);
    __syncthreads();
}

__device__ __forceinline__ void panel_sync(unsigned* cnt, unsigned target) {
    asm volatile("s_waitcnt vmcnt(0)" ::: "memory");
    __syncthreads();
    if (threadIdx.x == 0) {
        __builtin_amdgcn_fence(__ATOMIC_RELEASE, "agent");
        asm volatile("s_waitcnt vmcnt(0)" ::: "memory");
        (void)xb_add(cnt, 1u);
        unsigned sp = 0;
        while (xb_ld(cnt) < target) { __builtin_amdgcn_s_sleep(1); if (++sp > (1u << 22)) break; }
        __builtin_amdgcn_fence(__ATOMIC_ACQUIRE, "agent");
        asm volatile("s_waitcnt vmcnt(0)" ::: "memory");
    }
    __syncthreads();
}
__device__ __forceinline__ void ctx_rows(Frame& F, int p, int q) {
    const int lane = F.lane;
    const bf16* YC = WSP(bf16, WS_YC); const float* SSQ = WSP(float, WS_SSQ); bf16* XN = WSP(bf16, WS_XN);
    for (int i = 0; i < 8; ++i) {
        const int cr = 256 * p + 64 * q + 8 * F.wave + i;
        Row16 xv, yv; ld_row_f32(F_ctx + (size_t)cr * D, lane, xv); ld_row_bf16(YC + (size_t)cr * D, lane, yv);
        const float sp = lane < 16 ? SSQ[(size_t)(ML + cr) * 16 + lane] : 0.f;
        const float rs = __builtin_amdgcn_rsqf(wave_sum(sp) * (1.f / D) + EPS);
        Row16 g2; ld_row_f32(WSP(float, WS_MODV) + ((size_t)0 * 5 + 4) * 3072 + 2048, lane, g2);
#pragma unroll
        for (int e = 0; e < 16; ++e) xv.v[e] += g2.v[e] * yv.v[e] * rs;
        float s2 = 0.f;
#pragma unroll
        for (int e = 0; e < 16; ++e) s2 += xv.v[e] * xv.v[e];
        const float rs2 = __builtin_amdgcn_rsqf(wave_sum(s2) * (1.f / D) + EPS);
        Row16 g1, sh; ld_row_f32(WSP(float, WS_MODV) + ((size_t)1 * 5 + 4) * 3072 + 1024, lane, g1); ld_row_f32(WSP(float, WS_MODV) + ((size_t)1 * 5 + 4) * 3072, lane, sh);
#pragma unroll
        for (int e = 0; e < 16; ++e) xv.v[e] = xv.v[e] * rs2 * g1.v[e] + sh.v[e];
        st_row_bf16(XN + (size_t)(ML + cr) * D, lane, xv);
    }
}

__global__ void __launch_bounds__(512, 2) fwd_mega(Args args) {
    extern __shared__ __attribute__((aligned(16))) unsigned char lds_raw[];
    Frame F;
    F.lds = (LAS unsigned char*)lds_raw;
    F.tid = threadIdx.x; F.lane = F.tid & 63; F.wave = __builtin_amdgcn_readfirstlane(F.tid >> 6); F.G = gridDim.x; F.bid = blockIdx.x;
    F.a = (const __attribute__((address_space(4))) Args*)__builtin_amdgcn_kernarg_segment_ptr();
    F.out = args.out; F.ws = args.ws;
    volatile LAS unsigned* MISC = (volatile LAS unsigned*)(F.lds + LDS_MISC);
    if (F.tid < 64) MISC[F.tid] = 0u;
    __syncthreads();
    XcdBarrier bar = xcd_barrier_post((unsigned*)(F.ws + WS_CTL) + 4096, MISC + 8);
    const int lo = args.ph_lo, hi = args.ph_hi;
    int ph = 0;
#ifdef TS_A
    if (F.bid == 0 && threadIdx.x == 0) ((unsigned long long*)(F.ws + WS_CTL + 512 * 1024))[0] = __builtin_amdgcn_s_memrealtime();
#endif
#define RELAUNDER() { int t_ = threadIdx.x; asm volatile("" : "+v"(t_)); F.tid = t_; F.lane = t_ & 63; F.wave = __builtin_amdgcn_readfirstlane(t_ >> 6); \
        const __attribute__((address_space(4))) Args* a_ = (const __attribute__((address_space(4))) Args*)__builtin_amdgcn_kernarg_segment_ptr(); asm volatile("" : "+s"(a_)); F.a = a_; F.ws = a_->ws; F.out = a_->out; }
#define PHASE_BEGIN if (ph >= lo && ph < hi) { RELAUNDER()
#ifdef TS_ARR
#define TS_ARRIVE() TS_MARK(40 + ph)
#else
#define TS_ARRIVE() do { } while (0)
#endif
#define PHASE_END   TS_ARRIVE(); if (ph + 1 < hi) xcd_barrier(bar); TS_REC(); } ++ph;
#ifndef REP_P0
#define REP_P0 1
#endif
#ifndef REP_A
#define REP_A 1
#endif
#ifndef REP_B
#define REP_B 1
#endif
#ifndef REP_C1
#define REP_C1 1
#endif
#ifndef REP_C2
#define REP_C2 1
#endif

    PHASE_BEGIN
        p0_prologue(F);
#if defined(TS_MP) && TS_MP == 90
        TS_MARK(90);
#endif
        RELAUNDER()
        flag_wait((unsigned*)(F.ws + WS_CTL) + 12352, 64u);
        fold_phase(F);
#if defined(TS_MP) && TS_MP == 91
        TS_MARK(91);
#endif
        RELAUNDER()
        flag_wait((unsigned*)(F.ws + WS_CTL) + 12288, 96u);
        row_phase(F, 0);
#if defined(TS_MP) && TS_MP == 92
        TS_MARK(92);
#endif
    PHASE_END
    for (int layer = 0; layer < 2; ++layer) {
        PHASE_BEGIN for (int rep = 0; rep < REP_A; ++rep) {
            const int GL = layer == 0 ? F.G : F.G - 16;
            EpiIn E{F.ws};
            if (F.bid < GL) {
                pg8::Gemm g{WSP(bf16, WS_XN), WSP(bf16, WS_BTIN) + (size_t)layer * NIN * D, D, D};
#if defined(TS_MG)
                if (layer == 0) g.ts = (unsigned long long*)(F.ws + WS_CTL + 512 * 1024);
#endif
                SchedA S{GL, F.bid, layer};
                pg8::gemm_phase(F.lds, g, S, E);
            } else {
                const int j = F.bid - GL, p = j >> 2, q = j & 3;
                unsigned* pc = (unsigned*)(F.ws + WS_CTL) + 8192 + 64 * p + 1024 * rep;
                {
                    pg8::Gemm g{WSP(bf16, WS_XN), WSP(bf16, WS_BTCAT), D, D};
                    SchedTile S{64 + p, q, 1}; EpiC1 E1{WSP(bf16, WS_MERGEDC) - (size_t)ML * 1024, WSP(unsigned char, WS_S)};
                    pg8::gemm_phase(F.lds, g, S, E1); }
                panel_sync(pc, 4u);
                {
                    pg8::Gemm g{WSP(bf16, WS_MERGEDC) - (size_t)ML * 1024, WSP(bf16, WS_BTOUT), D, D};
                    SchedTile S{64 + p, q, 0}; EpiC2 E2{WSP(bf16, WS_YC) - (size_t)ML * 1024, WSP(float, WS_SSQ)};
                    pg8::gemm_phase(F.lds, g, S, E2); }
                panel_sync(pc, 8u);
                ctx_rows(F, p, q);
                panel_sync(pc, 12u);
                {
                    pg8::Gemm g{WSP(bf16, WS_XN), WSP(bf16, WS_BTIN) + (size_t)NIN * D, D, D};
                    SchedTile S{64 + p, 2 + q, 0};
                    if (q < 2) pg8::gemm_phase(F.lds, g, S, E); else { EpiV EV{F.ws}; pg8::gemm_phase<true>(F.lds, g, S, EV); } }
            } }
        PHASE_END
        PHASE_BEGIN for (int rep = 0; rep < REP_B; ++rep) {
#ifndef B_MASK
#define B_MASK 31
#endif
#ifndef REP_ATT
#define REP_ATT 1
#endif
#ifndef REP_FOUR
#define REP_FOUR 1
#endif
#ifndef REP_CONV
#define REP_CONV 1
#endif
            const int rbw = F.bid & 15, iw = F.bid >> 4;
            const int cj = layer != 0 ? -1 : (rbw == 0 ? (iw >= 4 ? iw - 4 : -1) : (rbw == 8 ? 12 + iw : ((rbw == 4 && iw < 4) ? 28 + iw : -1)));
            FourPre fp;
            if (B_MASK & 1) { AttnPre pa{}, pb{};
                attn_pre(F, F.bid, layer, pa);
                const int nu = cj >= 0 ? 3 : 2;
#pragma unroll 1
                for (int k = 0; k + 1 < nu; ++k) { const int u = F.bid + 256 * k, un = k == 1 ? 512 + cj : F.bid + 256;
                    attn_unit<false>(F, u, layer, pa, un, pb, -1, fp); pa = pb; }
                attn_unit<true>(F, nu == 3 ? 512 + cj : F.bid + 256, layer, pa, -1, pb, F.bid, fp); }
            else four_pre(F, F.bid, fp);
#if defined(TS_MB) && TS_MB == 30
            TS_MARK(30 + 5 * layer);
#endif
            RELAUNDER()
            if (B_MASK & 2) four_item(F, F.bid, fp);
#if defined(TS_MB) && TS_MB == 31
            TS_MARK(31 + 5 * layer);
#endif
            RELAUNDER()
            if (B_MASK & 4) for (int r2 = 0; r2 < REP_CONV; ++r2) for (int it = F.bid; it < 256; it += F.G) conv_item(F, it, layer);
#if defined(TS_MB) && TS_MB == 32
            TS_MARK(32 + 5 * layer);
#endif
            RELAUNDER()
            if ((B_MASK & 24) && layer == 0) {
                if ((B_MASK & 16) && rbw == 15) conv_item(F, 256 + iw, layer);
                if ((B_MASK & 8) && rbw == 0 && iw < 4) {
                    pg8::Gemm g{WSP(bf16, WS_DCTX), WSP(bf16, WS_ZT), 512, 512};
                    SchedFc S{iw}; EpiFc E{WSP(bf16, WS_XN), WSP(bf16, WS_GF)};
                    pg8::gemm_phase(F.lds, g, S, E);
                }
            } }
        PHASE_END
        PHASE_BEGIN
            if (F.bid < 256) {
                int pm, pn; pg8::tile_of(F.bid, 64, 4, pm, pn);
                unsigned* pc = (unsigned*)(F.ws + WS_CTL) + 16384 + layer * 4096 + pm * 64;
                {   pg8::Gemm g{WSP(bf16, WS_XN), WSP(bf16, WS_BTCAT) + (size_t)layer * D * D, D, D}; g.A2 = WSP(bf16, WS_AFL);
                    SchedTile S{pm, pn, 1}; EpiC1 E{WSP(bf16, WS_MERGED), WSP(unsigned char, WS_S)};
                    pg8::gemm_phase<false, true>(F.lds, g, S, E); }
#if defined(TS_MC) && TS_MC == 21
                if (layer == 0) TS_MARK(21);
#endif
                panel_sync(pc, 4u);
#if defined(TS_MC) && TS_MC == 22
                if (layer == 0) TS_MARK(22);
#endif
                {   pg8::Gemm g{WSP(bf16, WS_MERGED), WSP(bf16, WS_BTOUT) + (size_t)layer * D * D, D, D};
                    SchedTile S{pm, pn, 0}; EpiC2 E{WSP(bf16, WS_Y), WSP(float, WS_SSQ)};
                    pg8::gemm_phase(F.lds, g, S, E); }
#if defined(TS_MC) && TS_MC == 23
                if (layer == 0) TS_MARK(23);
#endif
                panel_sync(pc, 8u);
#if defined(TS_MC) && TS_MC == 24
                if (layer == 0) TS_MARK(24);
#endif
                RELAUNDER()
                row_run(F, layer + 1, pm >> 4, pm * 256 + 64 * pn + 8 * F.wave, 1, 8);
#if defined(TS_MC) && TS_MC == 25
                if (layer == 0) TS_MARK(25);
#endif
            }
        PHASE_END
    }
}
#ifndef PH_HI
#define PH_HI 7
#endif
constexpr int N_PHASES = PH_HI;

extern "C" void kernel_launch(void* const* d_in, const int* in_sizes, int n_in, void* d_out, int out_size, void* d_ws, size_t ws_size, hipStream_t stream) {
    static int grid = 0;
    if (grid == 0) {
        int dev = 0, cus = 0, per_cu = 0;
        if (n_in != 20 || ws_size < WS_END) { fprintf(stderr, "kernel_launch: unexpected n_in %d / ws %zu\n", n_in, ws_size); grid = -1; return; }
        hipGetDevice(&dev); hipDeviceGetAttribute(&cus, hipDeviceAttributeMultiprocessorCount, dev);
        if (hipFuncSetAttribute((const void*)fwd_mega, hipFuncAttributeMaxDynamicSharedMemorySize, LDS_BYTES) != hipSuccess) { fprintf(stderr, "kernel_launch: hipFuncSetAttribute failed\n"); grid = -1; return; }
        hipOccupancyMaxActiveBlocksPerMultiprocessor(&per_cu, (const void*)fwd_mega, 512, LDS_BYTES);
        (void)hipGetLastError();
        if (per_cu < 1) { fprintf(stderr, "kernel_launch: occupancy query says %d blocks/CU\n", per_cu); grid = -1; return; }
        if (cus < 256) { fprintf(stderr, "kernel_launch: built for a 256-CU device, found %d CUs\n", cus); grid = -1; return; }
        grid = 256;
    }
    if (grid < 0) return;
    hipMemsetAsync((char*)d_ws + WS_CTL, 0, 128 * KiB, stream);
    Args a{};
    for (int i = 0; i < 20; ++i) a.in[i] = (const float*)d_in[i];
    a.out = (float*)d_out; a.ws = (unsigned char*)d_ws; a.ph_lo = 0; a.ph_hi = N_PHASES;
    hipLaunchKernelGGL(fwd_mega, dim3(grid), dim3(512), LDS_BYTES, stream, a);
}
```

```cpp
#include <hip/hip_runtime.h>
#include <cstdio>
#include <cstdint>

#define LAS __attribute__((address_space(3)))
typedef unsigned short bf16;
typedef short bf16x8 __attribute__((ext_vector_type(8)));
typedef float f32x4 __attribute__((ext_vector_type(4)));
typedef float f32x16 __attribute__((ext_vector_type(16)));
typedef unsigned u32x4 __attribute__((ext_vector_type(4)));
typedef unsigned u32x2 __attribute__((ext_vector_type(2)));

constexpr int D = 1024, NB = 4, SEQ = 4096, CTX = 256, NH = 8;
constexpr int ML = NB * SEQ, MC = NB * CTX, MT = ML + MC;
constexpr int INW = 6400, NIN = 6656;
constexpr int OUF = 2048, OCA = 2560, OCB = 2816;
constexpr float EPS = 1e-6f;
constexpr float QSCALE = 0.125f * 1.44269504088896f;
constexpr float LOG2E = 1.44269504088896f;

constexpr size_t KiB = 1024, MiB = 1024 * 1024;
constexpr size_t WS_CTL = 0;
constexpr size_t WS_MODV = 1 * MiB;
constexpr size_t WS_WCS = WS_MODV + 128 * KiB;
constexpr size_t WS_D1T = WS_WCS + 1 * MiB;
constexpr size_t WS_E2T = WS_D1T + 32 * KiB;
constexpr size_t WS_TW = WS_E2T + 16 * KiB;
constexpr size_t WS_DCTX = WS_TW + 32 * KiB;
constexpr size_t WS_SSQ = WS_DCTX + 256 * KiB;
constexpr size_t WS_CTX1 = WS_SSQ + 1088 * KiB;
constexpr size_t WS_BTIN = 8 * MiB;
constexpr size_t WS_BTCAT = WS_BTIN + 26 * MiB;
constexpr size_t WS_BTOUT = WS_BTCAT + 4 * MiB;
constexpr size_t WS_BTPW = WS_BTOUT + 4 * MiB;
constexpr size_t WS_XN = 43 * MiB;
constexpr size_t WS_Q = WS_XN + 34 * MiB;
constexpr size_t WS_K = WS_Q + 17 * MiB;
constexpr size_t WS_MERGED = WS_Q;
constexpr size_t WS_VTL = WS_K + 17 * MiB;
constexpr size_t WS_VTC = WS_VTL + 16 * MiB;
constexpr size_t WS_GA = WS_VTC + 1 * MiB;
constexpr size_t WS_Y = WS_VTL;
constexpr size_t WS_UFL = WS_GA + 17 * MiB;
constexpr size_t WS_ZT = WS_UFL + 16 * MiB;
constexpr size_t WS_GF = WS_ZT + 1 * MiB;
constexpr size_t WS_GLU = WS_GF + 8704 * KiB;
constexpr size_t WS_GC = WS_GLU + 8704 * KiB;
constexpr size_t WS_S = WS_GC + 8704 * KiB;
constexpr size_t WS_MERGEDC = WS_S + 51 * MiB;
constexpr size_t WS_YC = WS_MERGEDC + 2 * MiB;
constexpr size_t WS_AFL = WS_YC + 2 * MiB;
constexpr size_t WS_END = WS_AFL + 8 * MiB;
static_assert(WS_CTX1 + 4 * MiB <= WS_BTIN && WS_BTPW + 256 * KiB <= WS_XN && WS_END <= 256 * MiB, "ws map");

constexpr int LDS_MISC = 147456;
constexpr int LDS_BYTES = 147456 + 1024;

typedef __bf16 bf16x2_t __attribute__((ext_vector_type(2)));
__device__ __forceinline__ unsigned cvt_pk_bf16(float lo, float hi) { bf16x2_t v; v.x = (__bf16)lo; v.y = (__bf16)hi; return __builtin_bit_cast(unsigned, v); }
__device__ __forceinline__ unsigned f2bf(float f) { unsigned u = __builtin_bit_cast(unsigned, f); return (u + 0x7fffu + ((u >> 16) & 1u)) >> 16; }
__device__ __forceinline__ float bflo(unsigned u) { return __builtin_bit_cast(float, u << 16); }
__device__ __forceinline__ float bfhi(unsigned u) { return __builtin_bit_cast(float, u & 0xffff0000u); }
__device__ __forceinline__ float bf2f(bf16 b) { return __builtin_bit_cast(float, (unsigned)b << 16); }
__device__ __forceinline__ float fast_sigmoid(float v) { return __builtin_amdgcn_rcpf(1.f + __builtin_amdgcn_exp2f(-v * LOG2E)); }
__device__ __forceinline__ float fast_silu(float v) { return v * fast_sigmoid(v); }
template <int CTRL, int ROWMASK> __device__ __forceinline__ float dpp_term(float v) {
    return __builtin_bit_cast(float, __builtin_amdgcn_update_dpp(0, __builtin_bit_cast(int, v), CTRL, ROWMASK, 0xf, false));
}
__device__ __forceinline__ float wave_sum(float v) {
    v += dpp_term<0xB1, 0xf>(v);
    v += dpp_term<0x4E, 0xf>(v);
    v += dpp_term<0x141, 0xf>(v);
    v += dpp_term<0x140, 0xf>(v);
    v += dpp_term<0x142, 0xa>(v);
    v += dpp_term<0x143, 0xc>(v);
    return __builtin_bit_cast(float, __builtin_amdgcn_readlane(__builtin_bit_cast(int, v), 63));
}
__device__ __forceinline__ void wave_sum8(float (&v)[8]) {
#pragma unroll
    for (int i = 0; i < 8; ++i) v[i] += dpp_term<0xB1, 0xf>(v[i]);
#pragma unroll
    for (int i = 0; i < 8; ++i) v[i] += dpp_term<0x4E, 0xf>(v[i]);
#pragma unroll
    for (int i = 0; i < 8; ++i) v[i] += dpp_term<0x141, 0xf>(v[i]);
#pragma unroll
    for (int i = 0; i < 8; ++i) v[i] += dpp_term<0x140, 0xf>(v[i]);
#pragma unroll
    for (int i = 0; i < 8; ++i) v[i] += dpp_term<0x142, 0xa>(v[i]);
#pragma unroll
    for (int i = 0; i < 8; ++i) v[i] += dpp_term<0x143, 0xc>(v[i]);
#pragma unroll
    for (int i = 0; i < 8; ++i) v[i] = __builtin_bit_cast(float, __builtin_amdgcn_readlane(__builtin_bit_cast(int, v[i]), 63));
}
#define LDS_WAIT() asm volatile("s_waitcnt lgkmcnt(0)" ::: "memory")
#define VM_WAIT() asm volatile("s_waitcnt vmcnt(0)" ::: "memory")

namespace pg8 {
constexpr int BM = 256, BK = 64, HALF = 128, HTB = HALF * BK * 2, STAGE_BYTES = 8 * HTB, NXCD = 8, WGM = 8;
__device__ __forceinline__ int lds_byte(int r, int c) { const int st = (r >> 4) * 2 + (c >> 5), rr = r & 15, cc = c & 31, ob = rr * 64 + cc * 2; return st * 1024 + (ob ^ (((ob >> 9) & 1) << 5)); }
__device__ __forceinline__ void stage_rc(int b, int& R, int& C) { const int st = b / 1024, sb = b % 1024, swz = sb ^ (((sb >> 9) & 1) << 5); R = (st >> 1) * 16 + swz / 64; C = (st & 1) * 32 + (swz % 64) / 2; }
__device__ __forceinline__ int perm32(int rho) { const int n = rho >> 4, i = rho & 15; return 8 * (i >> 2) + 4 * n + (i & 3); }

struct Unit { int pm, pn, k0, nt, tag, amode; };
struct Gemm { const bf16* A; const bf16* Bt; int lda, ldb; unsigned long long* ts = nullptr; const bf16* A2 = nullptr; };

__device__ __forceinline__ void tile_of(int L, int nM, int nN, int& pm, int& pn) {
    const int nwg = nM * nN; int wgid = L; { const int q = nwg / NXCD, r = nwg % NXCD, xcd = wgid % NXCD, off = wgid / NXCD; wgid = (xcd < r ? xcd * (q + 1) : r * (q + 1) + (xcd - r) * q) + off; }
    const int nig = WGM * nN, gid = wgid / nig, fm = gid * WGM, gsz = (nM - fm) < WGM ? (nM - fm) : WGM;
    pm = fm + ((wgid % nig) % gsz); pn = (wgid % nig) / gsz;
}

struct APar { const char* base; unsigned kstep, hstep, d1, vo; };
template <bool SWAP = false, bool AMODES = false, class Epi, class Sched>
__device__ __forceinline__ void gemm_phase(LAS unsigned char* lds, const Gemm g, const Sched& S, const Epi& E) {
    int tid_ = threadIdx.x; asm volatile("" : "+v"(tid_));
    const int tid = tid_, wid = __builtin_amdgcn_readfirstlane(tid >> 6), lane = tid & 63, wr = wid >> 2, wc = wid & 3, fr = lane & 15, fq = lane >> 4;
    unsigned voffB[2]; unsigned vo0, vo1;
    { int R, C; stage_rc(tid * 16, R, C); vo0 = (unsigned)(R * g.lda + C) * 2u; vo1 = (unsigned)((C >> 3) * 4096 + R) * 16u;
#pragma unroll
      for (int i = 0; i < 2; ++i) { int R2, C2; stage_rc(tid * 16 + i * 8192, R2, C2); const int Rb = (R2 & ~31) + perm32(R2 & 31); voffB[i] = (unsigned)(Rb * g.ldb + C2) * 2u; } }
    const size_t kstep = (size_t)(BK * 2);
    const size_t hstepB = (size_t)HALF * g.ldb * 2;
    const unsigned ldsw = (unsigned)wid * 1024u;
    const int aoff = lds_byte(wr * 64 + fr, fq * 8), boff = lds_byte(wc * 32 + fr, fq * 8);
#define PG8_APAR(P, u) do { if (AMODES && (u).amode) { (P).base = (const char*)g.A2 + ((size_t)(((u).pm >> 4) * 32 + (((u).k0 - 512) >> 3)) * 4096 + (size_t)(((u).pm & 15) * 256)) * 16; \
            (P).kstep = 8u * 4096u * 16u; (P).hstep = 2048u; (P).d1 = 1024u; (P).vo = vo1; } \
        else { (P).base = (const char*)(g.A + (size_t)(u).pm * BM * g.lda + (u).k0); (P).kstep = (unsigned)(BK * 2); (P).hstep = (unsigned)(HALF * g.lda * 2); (P).d1 = (unsigned)(64 * g.lda * 2); (P).vo = vo0; } } while (0)
#define PG8_SA(b, h) (((b) * 2 + (h)) * HTB)
#define PG8_SB(b, h) ((4 + (b) * 2 + (h)) * HTB)
#define PG8_STAGE(bufoff, gbase, voff) do { _Pragma("unroll") for (int _i = 0; _i < 2; ++_i) \
        __builtin_amdgcn_global_load_lds((const unsigned*)((const char*)(gbase) + (voff)[_i]), (LAS unsigned*)(lds + (bufoff) + ldsw + _i * 8192), 16, 0, 0); } while (0)
#define PG8_STAGE_A(bufoff, gbase, P) do { \
        __builtin_amdgcn_global_load_lds((const unsigned*)((const char*)(gbase) + (P).vo), (LAS unsigned*)(lds + (bufoff) + ldsw), 16, 0, 0); \
        __builtin_amdgcn_global_load_lds((const unsigned*)((const char*)(gbase) + (P).d1 + (P).vo), (LAS unsigned*)(lds + (bufoff) + ldsw + 8192), 16, 0, 0); } while (0)
#define PG8_LDA(dst, b, h) do { _Pragma("unroll") for (int m = 0; m < 4; ++m) _Pragma("unroll") for (int k = 0; k < 2; ++k) dst[m][k] = *(const LAS bf16x8*)(lds + PG8_SA(b, h) + aoff + m * 2048 + k * 1024); } while (0)
#define PG8_LDB(dst, b, h) do { _Pragma("unroll") for (int n = 0; n < 2; ++n) _Pragma("unroll") for (int k = 0; k < 2; ++k) dst[n][k] = *(const LAS bf16x8*)(lds + PG8_SB(b, h) + boff + n * 2048 + k * 1024); } while (0)
#define PG8_MMA(ai, bj, At, Bt) do { __builtin_amdgcn_s_setprio(1); _Pragma("unroll") for (int m = 0; m < 4; ++m) _Pragma("unroll") for (int n = 0; n < 2; ++n) _Pragma("unroll") for (int k = 0; k < 2; ++k) \
        acc[ai][bj][m][n] = SWAP ? __builtin_amdgcn_mfma_f32_16x16x32_bf16(At[m][k], Bt[n][k], acc[ai][bj][m][n], 0, 0, 0) : __builtin_amdgcn_mfma_f32_16x16x32_bf16(Bt[n][k], At[m][k], acc[ai][bj][m][n], 0, 0, 0); __builtin_amdgcn_s_setprio(0); } while (0)
#define PG8_WAIT_V(n) asm volatile("s_waitcnt vmcnt(" #n ")" ::: "memory")
#define PG8_WAIT_L(n) asm volatile("s_waitcnt lgkmcnt(" #n ")" ::: "memory")
#define PG8_BAR __builtin_amdgcn_s_barrier()
#define PG8_SCHED __builtin_amdgcn_sched_barrier(0)
    Unit cur{}, nxt{}; int ui = 0;
    if (!S.next(0, cur)) return;
    f32x4 acc[2][2][4][2];
#pragma unroll
    for (int a = 0; a < 2; ++a)
#pragma unroll
        for (int b = 0; b < 2; ++b)
#pragma unroll
            for (int m = 0; m < 4; ++m)
#pragma unroll
                for (int n = 0; n < 2; ++n) acc[a][b][m][n] = (f32x4){0.f, 0.f, 0.f, 0.f};
    bf16x8 At[4][2], B0[2][2], B1[2][2];
    APar pc; PG8_APAR(pc, cur);
    const char* cB = (const char*)(g.Bt + (size_t)cur.pn * BM * g.ldb + cur.k0);
    PG8_STAGE(PG8_SB(0, 0), cB, voffB); PG8_STAGE(PG8_SB(0, 1), cB + hstepB, voffB); PG8_STAGE_A(PG8_SA(0, 0), pc.base, pc); PG8_STAGE_A(PG8_SA(0, 1), pc.base + pc.hstep, pc);
    if (wr == 1) PG8_BAR;
    PG8_WAIT_V(2); PG8_BAR;
    PG8_STAGE(PG8_SB(1, 0), cB + kstep, voffB); PG8_STAGE_A(PG8_SA(1, 0), pc.base + pc.kstep, pc); PG8_STAGE(PG8_SB(1, 1), cB + hstepB + kstep, voffB);
    PG8_WAIT_V(6); PG8_BAR;
    for (;;) {
        const bool has_next = S.next(ui + 1, nxt);
        APar pn2 = pc; if (has_next) PG8_APAR(pn2, nxt);
        const char* nB = has_next ? (const char*)(g.Bt + (size_t)nxt.pn * BM * g.ldb + nxt.k0) : cB;
        const int nt = cur.nt;
        for (int t = 0; t < nt; t += 2) {
            const bool last = (t == nt - 2);
            const char* a1 = pc.base + (size_t)(t + 1) * pc.kstep;
            APar p2; p2.base = last ? pn2.base : pc.base + (size_t)(t + 2) * pc.kstep; p2.kstep = last ? pn2.kstep : pc.kstep; p2.hstep = last ? pn2.hstep : pc.hstep; p2.d1 = last ? pn2.d1 : pc.d1; p2.vo = last ? pn2.vo : pc.vo;
            const char* b2 = last ? nB : cB + (size_t)(t + 2) * kstep;
            const char* a3 = p2.base + p2.kstep; const char* b3 = b2 + kstep;
            PG8_LDB(B0, 0, 0); PG8_LDB(B1, 0, 1); PG8_SCHED; PG8_LDA(At, 0, 0); PG8_STAGE_A(PG8_SA(1, 1), a1 + pc.hstep, pc);
            PG8_WAIT_V(8); PG8_WAIT_L(0); PG8_BAR; PG8_MMA(0, 0, At, B0); PG8_MMA(0, 1, At, B1); PG8_BAR; PG8_SCHED;
            PG8_LDA(At, 0, 1); PG8_STAGE(PG8_SB(0, 0), b2, voffB); PG8_STAGE(PG8_SB(0, 1), b2 + hstepB, voffB); PG8_STAGE_A(PG8_SA(0, 0), p2.base, p2);
            PG8_WAIT_V(8); PG8_WAIT_L(0); PG8_BAR; PG8_MMA(1, 0, At, B0); PG8_MMA(1, 1, At, B1); PG8_BAR; PG8_SCHED;
            PG8_LDB(B0, 1, 0); PG8_LDB(B1, 1, 1); PG8_SCHED; PG8_LDA(At, 1, 0); PG8_STAGE_A(PG8_SA(0, 1), p2.base + p2.hstep, p2);
            PG8_WAIT_V(8); PG8_WAIT_L(0); PG8_BAR; PG8_MMA(0, 0, At, B0); PG8_MMA(0, 1, At, B1); PG8_BAR; PG8_SCHED;
            PG8_LDA(At, 1, 1); PG8_STAGE(PG8_SB(1, 0), b3, voffB); PG8_STAGE(PG8_SB(1, 1), b3 + hstepB, voffB); PG8_STAGE_A(PG8_SA(1, 0), a3, p2);
            PG8_WAIT_V(8); PG8_WAIT_L(0); PG8_BAR; PG8_MMA(1, 0, At, B0); PG8_MMA(1, 1, At, B1); PG8_BAR; PG8_SCHED;
        }
#if defined(TS_MG)
        if (g.ts && tid == 0 && (int)blockIdx.x == TS_WG && TS_MG == 70 + 2 * ui) g.ts[70 + 2 * ui] = __builtin_amdgcn_s_memrealtime();
#endif
        if (wr == 0) PG8_BAR;
        const bool keep = E(acc, cur, wr, wc, fr, fq);
#if defined(TS_MG)
        if (g.ts && tid == 0 && (int)blockIdx.x == TS_WG && TS_MG == 71 + 2 * ui) g.ts[71 + 2 * ui] = __builtin_amdgcn_s_memrealtime();
#endif
        if (!has_next) break;
        if (!keep) {
#pragma unroll
        for (int a = 0; a < 2; ++a)
#pragma unroll
            for (int b = 0; b < 2; ++b)
#pragma unroll
                for (int m = 0; m < 4; ++m)
#pragma unroll
                    for (int n = 0; n < 2; ++n) acc[a][b][m][n] = (f32x4){0.f, 0.f, 0.f, 0.f}; }
        cur = nxt; pc = pn2; cB = nB; ++ui;
        if (wr == 1) PG8_BAR;
    }
    PG8_WAIT_V(0);
    PG8_BAR;
#undef PG8_SA
#undef PG8_SB
#undef PG8_STAGE
#undef PG8_STAGE_A
#undef PG8_APAR
#undef PG8_LDA
#undef PG8_LDB
#undef PG8_MMA
#undef PG8_WAIT_V
#undef PG8_WAIT_L
#undef PG8_BAR
#undef PG8_SCHED
}
}
using pg8::Unit;
typedef f32x4 (&AccRef)[2][2][4][2];

#define XB_TMO      128
#define XB_XCNT(j)  (256  + 64 * (j))
#define XB_XSUB(j)  (1280 + 64 * (j))
#define XB_XGEN(j)  (2304 + 64 * (j))
#define XB_TOP      3328
#define XB_TOPGEN   3392
#define XCD_BAR_WORDS 3456
#define XB_SPIN_CAP (1u << 18)
__device__ __forceinline__ unsigned xb_ld(unsigned* p)              { return __hip_atomic_load(p, __ATOMIC_RELAXED, __HIP_MEMORY_SCOPE_AGENT); }
__device__ __forceinline__ unsigned xb_add(unsigned* p, unsigned v) { return __hip_atomic_fetch_add(p, v, __ATOMIC_RELAXED, __HIP_MEMORY_SCOPE_AGENT); }
__device__ __forceinline__ unsigned xb_xcc_id() { return (unsigned)__builtin_amdgcn_s_getreg((3 << 11) | 20) & 0xFu; }
#define XB_SPIN(cond, bar) do { unsigned _sp = 0; while (cond) { __builtin_amdgcn_s_sleep(1); \
    if ((++_sp & 255u) == 0u) { if (xb_ld(&(bar)[XB_TMO])) break; if (_sp > XB_SPIN_CAP) { atomicAdd(&(bar)[XB_TMO], 1u); break; } } } } while (0)
struct XcdBarrier { unsigned* bar; unsigned x; volatile LAS unsigned* st; };
__device__ __forceinline__ XcdBarrier xcd_barrier_post(unsigned* bar, volatile LAS unsigned* st) {
    XcdBarrier b; b.bar = bar; b.x = xb_xcc_id(); b.st = st;
    if (threadIdx.x == 0) (void)xb_add(&bar[XB_XCNT(b.x)], 1u);
    return b;
}
__device__ __forceinline__ void xcd_barrier_complete(unsigned* bar, unsigned x, unsigned& nloc, unsigned& nx) {
    const unsigned G = gridDim.x * gridDim.y * gridDim.z;
    unsigned sum, cnt, mine, sp = 0u;
    for (;;) {
        sum = 0u; cnt = 0u; mine = 0u;
#pragma unroll
        for (unsigned j = 0; j < 16; ++j) { const unsigned c = xb_ld(&bar[XB_XCNT(j)]); sum += c; cnt += (c > 0u) ? 1u : 0u; mine = (j == x) ? c : mine; }
        if (sum == G) break;
        __builtin_amdgcn_s_sleep(1);
        if ((++sp & 255u) == 0u) { if (xb_ld(&bar[XB_TMO])) break; if (sp > XB_SPIN_CAP) { atomicAdd(&bar[XB_TMO], 1u); break; } }
    }
    nloc = mine > 0u ? mine : 1u; nx = cnt > 0u ? cnt : 1u;
}
__device__ __forceinline__ void xcd_barrier(const XcdBarrier& b) {
    asm volatile("s_waitcnt vmcnt(0)" ::: "memory");
    __syncthreads();
    if (b.st[0] == 0u) {
        if (threadIdx.x < 64) {
            const unsigned G = gridDim.x * gridDim.y * gridDim.z; const unsigned lane = threadIdx.x; unsigned sp = 0u, c = 0u; float sum = 0.f, cnt = 0.f;
            for (;;) {
                c = lane < 16u ? xb_ld(&b.bar[XB_XCNT(lane)]) : 0u;
                sum = wave_sum((float)c); cnt = wave_sum(c > 0u ? 1.f : 0.f);
                if ((unsigned)sum == G) break;
                __builtin_amdgcn_s_sleep(1);
                if ((++sp & 255u) == 0u) { if (xb_ld(&b.bar[XB_TMO])) break; if (sp > XB_SPIN_CAP) { if (lane == 0u) atomicAdd(&b.bar[XB_TMO], 1u); break; } }
            }
            const unsigned mine = (unsigned)__builtin_amdgcn_readlane((int)c, (int)__builtin_amdgcn_readfirstlane((int)b.x)), nxc = (unsigned)cnt;
            if (lane == 0u) { b.st[0] = mine > 0u ? mine : 1u; b.st[1] = nxc > 0u ? nxc : 1u; }
        }
        __syncthreads();
    }
    if (threadIdx.x == 0) {
        unsigned* bar = b.bar;
        __builtin_amdgcn_s_waitcnt(0);
        const unsigned nloc = b.st[0], nx = b.st[1];
        const unsigned old = xb_add(&bar[XB_XSUB(b.x)], 1u);
        const unsigned gen = old / nloc;
        if (old + 1u == (gen + 1u) * nloc) {
            __builtin_amdgcn_fence(__ATOMIC_RELEASE, "agent");
            asm volatile("s_waitcnt vmcnt(0)" ::: "memory");
            const unsigned og = xb_add(&bar[XB_TOP], 1u);
            const unsigned tg = og / nx;
            if (og + 1u == (tg + 1u) * nx) xb_add(&bar[XB_TOPGEN], 1u);
            else XB_SPIN(xb_ld(&bar[XB_TOPGEN]) == tg, bar);
            __builtin_amdgcn_fence(__ATOMIC_ACQUIRE, "agent");
            xb_add(&bar[XB_XGEN(b.x)], 1u);
            asm volatile("s_waitcnt vmcnt(0)" ::: "memory");
        } else {
            XB_SPIN(xb_ld(&bar[XB_XGEN(b.x)]) == gen, bar);
            __builtin_amdgcn_fence(__ATOMIC_ACQUIRE, "agent");
            asm volatile("s_waitcnt vmcnt(0)" ::: "memory");
        }
    }
    __syncthreads();
}

__device__ __forceinline__ void flag_signal(unsigned* cnt) {
    asm volatile("s_waitcnt vmcnt(0)" ::: "memory");
    __syncthreads();
    if (threadIdx.x == 0) { __builtin_amdgcn_fence(__ATOMIC_RELEASE, "agent"); asm volatile("s_waitcnt vmcnt(0)" ::: "memory"); (void)xb_add(cnt, 1u); }
}
__device__ __forceinline__ void flag_wait(unsigned* cnt, unsigned target) {
    if (threadIdx.x == 0) { unsigned sp = 0; while (xb_ld(cnt) < target) { __builtin_amdgcn_s_sleep(2); if (++sp > (1u << 22)) break; }
        __builtin_amdgcn_fence(__ATOMIC_ACQUIRE, "agent"); asm volatile("s_waitcnt vmcnt(0)" ::: "memory"); }
    __syncthreads();
}
struct Args { const float* in[20]; float* out; unsigned char* ws; int ph_lo, ph_hi; };
struct Frame {
    LAS unsigned char* lds;
    int tid, lane, wave, G, bid;
    const __attribute__((address_space(4))) Args* a;
    float* out; unsigned char* ws;
};
#define F_x (F.a->in[0])
#define F_c (F.a->in[1])
#define F_ctx (F.a->in[2])
#define F_cctx (F.a->in[3])
#define F_wmod (F.a->in[4])
#define F_bmod (F.a->in[5])
#define F_gpre (F.a->in[6])
#define F_gpost (F.a->in[7])
#define F_win (F.a->in[8])
#define F_rpb (F.a->in[9])
#define F_wfour (F.a->in[10])
#define F_cdw (F.a->in[11])
#define F_cdb (F.a->in[12])
#define F_lng (F.a->in[13])
#define F_lnb (F.a->in[14])
#define F_wpw (F.a->in[15])
#define F_pattn (F.a->in[16])
#define F_pfour (F.a->in[17])
#define F_pconv (F.a->in[18])
#define F_wout (F.a->in[19])
#define WSP(T, off) ((T*)(F.ws + (off)))
#ifdef TS_A
#define TS_REC() do { if (F.bid == 0 && threadIdx.x == 0) ((unsigned long long*)(F.ws + WS_CTL + 512 * 1024))[ph + 1] = __builtin_amdgcn_s_memrealtime(); } while (0)
#define TS_MARK(slot) do { if (threadIdx.x == 0) { unsigned long long* tp_ = (unsigned long long*)(F.ws + WS_CTL + 512 * 1024) + (slot); if (TS_WG == -2) atomicMax(tp_, ((unsigned long long)__builtin_amdgcn_s_memrealtime() << 9) | (unsigned long long)F.bid); else if (TS_WG < 0) atomicMax(tp_, (unsigned long long)__builtin_amdgcn_s_memrealtime()); else if (F.bid == TS_WG) *tp_ = __builtin_amdgcn_s_memrealtime(); } } while (0)
#else
#define TS_REC() do { } while (0)
#define TS_MARK(slot) do { } while (0)
#endif

__device__ __forceinline__ int win_dstrow(int c) {
    if (c < 2048) return c;
    if (c < 2304) return -1;
    if (c < 2560) return c + 256;
    if (c < 2816) { const int j = c - 2560; return 2816 + (j >> 7) * 256 + (j & 127); }
    if (c < 3072) { const int j = c - 2816; return 2816 + (j >> 7) * 256 + 128 + (j & 127); }
    return c + 256;
}
__device__ __forceinline__ void transpose_item(const float* W, int ldw, int k0, int n0, bf16* dst, int ldk, int dstrow0, int dstk0, LAS float* scr, int lane) {
#pragma unroll
    for (int i = 0; i < 32; ++i) { const int kk = 2 * i + (lane >> 5); scr[kk * 33 + (lane & 31)] = W[(size_t)(k0 + kk) * ldw + n0 + (lane & 31)]; }
    LDS_WAIT(); asm volatile("" ::: "memory");
    const int c = lane & 7;
#pragma unroll
    for (int j = 0; j < 4; ++j) { const int n = (lane >> 3) + 8 * j; const LAS float* s = scr + (8 * c) * 33 + n;
        u32x4 o; o.x = cvt_pk_bf16(s[0], s[33]); o.y = cvt_pk_bf16(s[66], s[99]); o.z = cvt_pk_bf16(s[132], s[165]); o.w = cvt_pk_bf16(s[198], s[231]);
        *(u32x4*)(dst + (size_t)(dstrow0 + n) * ldk + dstk0 + k0 + 8 * c) = o; }
    LDS_WAIT(); asm volatile("" ::: "memory");
}
struct TDesc { const float* src; bf16* dst; int ldw, ldk; };
__device__ __forceinline__ void t_desc(Frame& F, int it, TDesc& d) {
    const int l = it / 4128; int r = it % 4128;
    if (r < 3072) { const int kb = r / 192, nb0 = r % 192, nb = nb0 < 64 ? nb0 : nb0 + 8; const int dr = win_dstrow(nb * 32);
        d.src = F_win + (size_t)l * D * INW + (size_t)(kb * 64) * INW + nb * 32; d.ldw = INW; d.dst = WSP(bf16, WS_BTIN) + (size_t)l * NIN * D + (size_t)dr * D + kb * 64; d.ldk = D; return; } r -= 3072;
    if (r < 256) { d.src = F_pattn + (size_t)l * 512 * D + (size_t)((r / 32) * 64) * D + (r % 32) * 32; d.ldw = D; d.dst = WSP(bf16, WS_BTCAT) + (size_t)l * D * D + (size_t)((r % 32) * 32) * D + (r / 32) * 64; d.ldk = D; return; } r -= 256;
    if (r < 128) { d.src = F_pfour + (size_t)l * 256 * D + (size_t)((r / 32) * 64) * D + (r % 32) * 32; d.ldw = D; d.dst = WSP(bf16, WS_BTCAT) + (size_t)l * D * D + (size_t)((r % 32) * 32) * D + 512 + (r / 32) * 64; d.ldk = D; return; } r -= 128;
    if (r < 128) { d.src = F_pconv + (size_t)l * 256 * D + (size_t)((r / 32) * 64) * D + (r % 32) * 32; d.ldw = D; d.dst = WSP(bf16, WS_BTCAT) + (size_t)l * D * D + (size_t)((r % 32) * 32) * D + 768 + (r / 32) * 64; d.ldk = D; return; } r -= 128;
    if (r < 512) { d.src = F_wout + (size_t)l * D * D + (size_t)((r / 32) * 64) * D + (r % 32) * 32; d.ldw = D; d.dst = WSP(bf16, WS_BTOUT) + (size_t)l * D * D + (size_t)((r % 32) * 32) * D + (r / 32) * 64; d.ldk = D; return; } r -= 512;
    d.src = F_wpw + (size_t)l * 65536 + (size_t)((r / 8) * 64) * 256 + (r % 8) * 32; d.ldw = 256; d.dst = WSP(bf16, WS_BTPW) + (size_t)l * 65536 + (size_t)((r % 8) * 32) * 256 + (r / 8) * 64; d.ldk = 256;
}
__device__ __forceinline__ void t_load(const TDesc& d, int lane, float (&v)[32]) {
#pragma unroll
    for (int i = 0; i < 32; ++i) v[i] = d.src[(size_t)(2 * i + (lane >> 5)) * d.ldw + (lane & 31)];
}
__device__ __forceinline__ void t_store(const TDesc& d, int lane, const float (&v)[32], LAS float* scr) {
#pragma unroll
    for (int i = 0; i < 32; ++i) scr[(2 * i + (lane >> 5)) * 33 + (lane & 31)] = v[i];
    LDS_WAIT(); asm volatile("" ::: "memory");
    const int c = lane & 7;
#pragma unroll
    for (int j = 0; j < 4; ++j) { const int n = (lane >> 3) + 8 * j; const LAS float* sp = scr + (8 * c) * 33 + n;
        u32x4 o; o.x = cvt_pk_bf16(sp[0], sp[33]); o.y = cvt_pk_bf16(sp[66], sp[99]); o.z = cvt_pk_bf16(sp[132], sp[165]); o.w = cvt_pk_bf16(sp[198], sp[231]);
        *(u32x4*)(d.dst + (size_t)n * d.ldk + 8 * c) = o; }
    LDS_WAIT(); asm volatile("" ::: "memory");
}
__device__ __forceinline__ void p0_prologue(Frame& F) {
    LAS float* scr = (LAS float*)(F.lds + F.wave * 16384);
    const int gw = F.bid * 8 + F.wave, NGW = F.G * 8, lane = F.lane;
    if (F.bid < 96) {
        LAS float* sc = (LAS float*)F.lds;
        LAS float* red = sc + 5 * 1024;
        for (int i = F.tid; i < 5 * 1024; i += 512) { const int r = i >> 10, k = i & 1023; sc[i] = fast_silu(r < 4 ? F_c[r * D + k] : F_cctx[k]); }
        __syncthreads();
        const int l = F.bid / 48, n = (F.bid % 48) * 64 + lane;
        const float* w = F_wmod + (size_t)l * D * 3072 + (size_t)(128 * F.wave) * 3072 + n;
        const LAS float* scw = sc + 128 * F.wave;
        float a0 = 0.f, a1 = 0.f, a2 = 0.f, a3 = 0.f, a4 = 0.f;
#pragma unroll 16
        for (int k = 0; k < 128; ++k) { const float wv = w[(size_t)k * 3072];
            a0 += scw[k] * wv; a1 += scw[1024 + k] * wv; a2 += scw[2048 + k] * wv; a3 += scw[3072 + k] * wv; a4 += scw[4096 + k] * wv; }
        LAS float* rw = red + (F.wave * 5) * 64 + lane;
        rw[0] = a0; rw[64] = a1; rw[128] = a2; rw[192] = a3; rw[256] = a4;
        __syncthreads();
        if (F.tid < 320) { const int q = F.tid >> 6;
            float v = 0.f;
#pragma unroll
            for (int ww = 0; ww < 8; ++ww) v += red[(ww * 5 + q) * 64 + lane];
            v += F_bmod[l * 3072 + n];
            if (n >= 2048) v = v * F_gpost[l * D + n - 2048];
            else if (n >= 1024) v = F_gpre[l * D + n - 1024] * (1.f + v);
            WSP(float, WS_MODV)[((size_t)l * 5 + q) * 3072 + n] = v; }
        flag_signal((unsigned*)(F.ws + WS_CTL) + 12288);
        __syncthreads();
    }
    LAS float* trig = (LAS float*)(F.lds + 8 * 16384);
    if (F.tid < 64) { float sn, cs; sincospif((float)F.tid * (1.f / 32.f), &sn, &cs); trig[F.tid] = cs; trig[64 + F.tid] = sn; }
    __syncthreads();
    for (int it = NGW - 1 - gw; it < 512; it += NGW) {
        const int l = it >> 8, row = it & 255, g = row >> 6, d = row & 63;
        const float* wf = F_wfour + (size_t)l * 65536 + (size_t)(g * 64) * 256 + lane;
        float ac[4] = {0.f, 0.f, 0.f, 0.f}, as[4] = {0.f, 0.f, 0.f, 0.f};
#pragma unroll 8
        for (int dp = 0; dp < 64; ++dp) { const int ix = (d * dp) & 63; const float cs = trig[ix], sn = trig[64 + ix];
#pragma unroll
            for (int q = 0; q < 4; ++q) { const float wv = wf[dp * 256 + 64 * q]; ac[q] += cs * wv; as[q] += sn * wv; } }
        float* wc = WSP(float, WS_WCS) + ((size_t)(l * 2 + 0) * 256 + row) * 256;
        float* wsn = WSP(float, WS_WCS) + ((size_t)(l * 2 + 1) * 256 + row) * 256;
#pragma unroll
        for (int q = 0; q < 4; ++q) { wc[lane + 64 * q] = ac[q] * 0.125f; wsn[lane + 64 * q] = as[q] * 0.125f; }
    }
    if (F.bid >= F.G - 64) flag_signal((unsigned*)(F.ws + WS_CTL) + 12352);
    {
        constexpr int NT = 2 * 4128;
        const int nw96 = 96 * 8, NSPLIT = NT - 2 * nw96;
        const bool small = F.bid < 96;
        const int stride = small ? nw96 : NGW - nw96, itend = small ? NT : NSPLIT;
        TDesc cur, nxt; float va[32], vb[32];
        int it = small ? NSPLIT + gw : gw - nw96;
        if (it < itend) { t_desc(F, it, cur); t_load(cur, lane, va); }
        while (it < itend) {
            const int itn = it + stride;
            if (itn < itend) { t_desc(F, itn, nxt); t_load(nxt, lane, vb); }
            t_store(cur, lane, va, scr);
            cur = nxt; it = itn;
#pragma unroll
            for (int i = 0; i < 32; ++i) va[i] = vb[i];
        }
    }
    const int gt = F.bid * 512 + F.tid, NGT = F.G * 512;
    for (int i = gt; i < 128 * 128; i += NGT) {
        const int n = i >> 7, k = i & 127, rip = n >> 6, k1 = n & 63, ri = k >> 6, n1 = k & 63;
        float sn, cs; sincospif((float)((k1 * n1) & 63) * (1.f / 32.f), &sn, &cs);
        const float v = rip == 0 ? (ri == 0 ? cs : -sn) : (ri == 0 ? -sn : -cs);
        WSP(bf16, WS_D1T)[i] = (bf16)f2bf(v);
    }
    for (int i = gt; i < 64 * 128; i += NGT) {
        const int k2 = i >> 7, k = i & 127, ri = k >> 6, n2 = k & 63;
        float sn, cs; sincospif((float)((k2 * n2) & 63) * (1.f / 32.f), &sn, &cs);
        WSP(bf16, WS_E2T)[i] = (bf16)f2bf((ri == 0 ? cs : sn) * (1.f / 64.f));
    }
    for (int i = gt; i < 64 * 64; i += NGT) {
        const int k1 = i >> 6, n2 = i & 63;
        float sn, cs; sincospif((float)(k1 * n2) * (1.f / 2048.f), &sn, &cs);
        WSP(float, WS_TW)[2 * i] = cs; WSP(float, WS_TW)[2 * i + 1] = sn;
    }
    for (int i = gt; i < 256 * 512; i += NGT) {
        const int k = i >> 9, kk = i & 511, ri = kk >> 8, n = kk & 255;
        float sn, cs; sincospif((float)((k * n) & 255) * (1.f / 128.f), &sn, &cs);
        WSP(bf16, WS_DCTX)[i] = (bf16)f2bf((ri == 0 ? cs : -sn) * (1.f / 16.f));
    }
}

struct Row16 { float v[16]; };
__device__ __forceinline__ void ld_row_f32(const float* p, int lane, Row16& r) {
#pragma unroll
    for (int j = 0; j < 2; ++j) { const f32x4 a = *(const f32x4*)(p + 512 * j + 8 * lane), b = *(const f32x4*)(p + 512 * j + 8 * lane + 4);
        r.v[8 * j + 0] = a.x; r.v[8 * j + 1] = a.y; r.v[8 * j + 2] = a.z; r.v[8 * j + 3] = a.w; r.v[8 * j + 4] = b.x; r.v[8 * j + 5] = b.y; r.v[8 * j + 6] = b.z; r.v[8 * j + 7] = b.w; }
}
__device__ __forceinline__ void st_row_f32(float* p, int lane, const Row16& r) {
#pragma unroll
    for (int j = 0; j < 2; ++j) { *(f32x4*)(p + 512 * j + 8 * lane) = (f32x4){r.v[8 * j], r.v[8 * j + 1], r.v[8 * j + 2], r.v[8 * j + 3]};
        *(f32x4*)(p + 512 * j + 8 * lane + 4) = (f32x4){r.v[8 * j + 4], r.v[8 * j + 5], r.v[8 * j + 6], r.v[8 * j + 7]}; }
}
__device__ __forceinline__ void ld_row_bf16(const bf16* p, int lane, Row16& r) {
#pragma unroll
    for (int j = 0; j < 2; ++j) { const u32x4 a = *(const u32x4*)(p + 512 * j + 8 * lane);
        r.v[8 * j + 0] = bflo(a.x); r.v[8 * j + 1] = bfhi(a.x); r.v[8 * j + 2] = bflo(a.y); r.v[8 * j + 3] = bfhi(a.y); r.v[8 * j + 4] = bflo(a.z); r.v[8 * j + 5] = bfhi(a.z); r.v[8 * j + 6] = bflo(a.w); r.v[8 * j + 7] = bfhi(a.w); }
}
__device__ __forceinline__ void st_row_bf16(bf16* p, int lane, const Row16& r) {
#pragma unroll
    for (int j = 0; j < 2; ++j) { u32x4 o; o.x = cvt_pk_bf16(r.v[8 * j], r.v[8 * j + 1]); o.y = cvt_pk_bf16(r.v[8 * j + 2], r.v[8 * j + 3]); o.z = cvt_pk_bf16(r.v[8 * j + 4], r.v[8 * j + 5]); o.w = cvt_pk_bf16(r.v[8 * j + 6], r.v[8 * j + 7]);
        *(u32x4*)(p + 512 * j + 8 * lane) = o; }
}
struct RowVecs { Row16 g2, g1, sh; };
__device__ __forceinline__ void row_apply(Frame& F, int mode, int row, bool lat, Row16& xv, const Row16& yv, float sp, const RowVecs& V) {
    const int lane = F.lane;
    if (mode != 0) {
        const float rs = __builtin_amdgcn_rsqf(wave_sum(sp) * (1.f / D) + EPS);
#pragma unroll
        for (int i = 0; i < 16; ++i) xv.v[i] += V.g2.v[i] * yv.v[i] * rs;
#ifdef DIAG_THR
        if (mode == 2) { const unsigned cntb = *(const unsigned*)(F.ws + WS_CTL + 768 * 1024);
            const float sc_ = 1.f + fminf((float)cntb, 1000.f) * 0.0005f;
#pragma unroll
            for (int i = 0; i < 16; ++i) xv.v[i] *= sc_; }
#endif
#ifdef TS_A
        if (mode == 2) { const unsigned long long* ts = (const unsigned long long*)(F.ws + WS_CTL + 512 * 1024);
#ifdef TS_ARGMAX
            float dA = (float)((ts[TS_B] >> TS_ARGMAX) & 15ull) * 10.f;
#else
            float dA = (float)(ts[TS_B] - ts[TS_A]) * 0.01f;
#endif
            dA = fminf(dA, (float)TS_CLAMP);
#pragma unroll
            for (int i = 0; i < 16; ++i) xv.v[i] *= (1.f + dA * (1.f / (float)TS_DIV)); }
#endif
        st_row_f32(F.out + (size_t)row * D, lane, xv);
    }
    if (mode != 2) {
        float s2 = 0.f;
#pragma unroll
        for (int i = 0; i < 16; ++i) s2 += xv.v[i] * xv.v[i];
        const float rs = __builtin_amdgcn_rsqf(wave_sum(s2) * (1.f / D) + EPS);
#pragma unroll
        for (int i = 0; i < 16; ++i) xv.v[i] = xv.v[i] * rs * V.g1.v[i] + V.sh.v[i];
        st_row_bf16(WSP(bf16, WS_XN) + (size_t)row * D, lane, xv);
    }
    (void)lat;
}
__device__ __forceinline__ void row_run(Frame& F, int mode, int b, int first, int stride, int nper) {
    const int lane = F.lane;
    const bf16* Y = WSP(bf16, WS_Y); const float* SSQ = WSP(float, WS_SSQ);
    const float* xsrc = mode == 2 ? F.out : F_x;
    RowVecs V;
#pragma unroll
    for (int i = 0; i < 16; ++i) { V.g2.v[i] = 0.f; V.g1.v[i] = 0.f; V.sh.v[i] = 0.f; }
    if (mode != 0) ld_row_f32(WSP(float, WS_MODV) + ((size_t)(mode - 1) * 5 + b) * 3072 + 2048, lane, V.g2);
    if (mode != 2) { ld_row_f32(WSP(float, WS_MODV) + ((size_t)mode * 5 + b) * 3072 + 1024, lane, V.g1); ld_row_f32(WSP(float, WS_MODV) + ((size_t)mode * 5 + b) * 3072, lane, V.sh); }
    Row16 xv, yv; float sp = 0.f;
#pragma unroll
    for (int i = 0; i < 16; ++i) yv.v[i] = 0.f;
    int row = first;
    ld_row_f32(xsrc + (size_t)row * D, lane, xv);
    if (mode != 0) { ld_row_bf16(Y + (size_t)row * D, lane, yv); sp = lane < 16 ? SSQ[(size_t)row * 16 + lane] : 0.f; }
    for (int i = 0; i < nper; ++i) {
        const int nrow = row + stride; Row16 nx, ny; float nsp = 0.f;
#pragma unroll
        for (int e = 0; e < 16; ++e) { nx.v[e] = 0.f; ny.v[e] = 0.f; }
        if (i + 1 < nper) { ld_row_f32(xsrc + (size_t)nrow * D, lane, nx); if (mode != 0) { ld_row_bf16(Y + (size_t)nrow * D, lane, ny); nsp = lane < 16 ? SSQ[(size_t)nrow * 16 + lane] : 0.f; } }
        row_apply(F, mode, row, true, xv, yv, sp, V);
        xv = nx; yv = ny; sp = nsp; row = nrow;
    }
}
__device__ __forceinline__ void row_phase(Frame& F, int mode) {
    const int gw = F.bid * 8 + F.wave, NGW = F.G * 8, lane = F.lane;
    const int QW = NGW / 4, b = gw / QW, li = gw % QW, nper = SEQ / QW;
    row_run(F, mode, b, b * SEQ + li, QW, nper);
    if (mode == 0 && gw < MC) {
        RowVecs V; Row16 xv, yv;
#pragma unroll
        for (int i = 0; i < 16; ++i) { V.g2.v[i] = 0.f; yv.v[i] = 0.f; }
        ld_row_f32(WSP(float, WS_MODV) + ((size_t)0 * 5 + 4) * 3072 + 1024, lane, V.g1); ld_row_f32(WSP(float, WS_MODV) + ((size_t)0 * 5 + 4) * 3072, lane, V.sh);
        ld_row_f32(F_ctx + (size_t)gw * D, lane, xv);
        row_apply(F, 0, ML + gw, false, xv, yv, 0.f, V);
    }
}
__device__ __forceinline__ void fold_phase(Frame& F) {
    LAS float* sW = (LAS float*)F.lds;
    LAS float* sA = (LAS float*)(F.lds + 65536) + F.wave * 2048;
    const int lane = F.lane, tid = F.tid;
    for (int id = F.bid; id < 256; id += F.G) {
        const int l = id >> 7, cs = (id >> 6) & 1, jq = (id >> 4) & 3, kg = id & 15, kb = kg * 8 + F.wave;
        const float* wcs = WSP(float, WS_WCS) + (size_t)(l * 2 + cs) * 65536 + 64 * jq;
        const float* wi = F_win + (size_t)l * D * INW + (size_t)(kb * 8) * INW + OUF;
        f32x4 pw[8], pa[8];
#pragma unroll
        for (int i = 0; i < 8; ++i) { const int idx = tid + 512 * i; pw[i] = *(const f32x4*)(wcs + (size_t)(idx >> 4) * 256 + 4 * (idx & 15)); }
#pragma unroll
        for (int i = 0; i < 8; ++i) pa[i] = *(const f32x4*)(wi + (size_t)i * INW + 4 * lane);
#pragma unroll
        for (int i = 0; i < 8; ++i) { const int idx = tid + 512 * i; *(LAS f32x4*)(sW + (idx >> 4) * 64 + 4 * (idx & 15)) = pw[i]; }
#pragma unroll
        for (int e = 0; e < 4; ++e) {
            *(LAS f32x4*)(sA + (4 * lane + e) * 8) = (f32x4){pa[0][e], pa[1][e], pa[2][e], pa[3][e]};
            *(LAS f32x4*)(sA + (4 * lane + e) * 8 + 4) = (f32x4){pa[4][e], pa[5][e], pa[6][e], pa[7][e]}; }
        __syncthreads();
        float a[8] = {0.f, 0.f, 0.f, 0.f, 0.f, 0.f, 0.f, 0.f};
#pragma unroll 8
        for (int m = 0; m < 256; ++m) { const float w = sW[m * 64 + lane]; const f32x4 x0 = *(const LAS f32x4*)(sA + m * 8), x1 = *(const LAS f32x4*)(sA + m * 8 + 4);
            a[0] += x0[0] * w; a[1] += x0[1] * w; a[2] += x0[2] * w; a[3] += x0[3] * w; a[4] += x1[0] * w; a[5] += x1[1] * w; a[6] += x1[2] * w; a[7] += x1[3] * w; }
        u32x4 o; o.x = cvt_pk_bf16(a[0], a[1]); o.y = cvt_pk_bf16(a[2], a[3]); o.z = cvt_pk_bf16(a[4], a[5]); o.w = cvt_pk_bf16(a[6], a[7]);
        *(u32x4*)(WSP(bf16, WS_BTIN) + (size_t)l * NIN * D + (size_t)(2048 + cs * 256 + 64 * jq + lane) * D + kb * 8) = o;
        __syncthreads();
    }
}

struct SchedA {
    int G, c, layer;
    __device__ __forceinline__ bool next(int i, Unit& u) const {
        const int L = i * G + c; const int nlat = 64 * 26, ntot = nlat + (layer == 0 ? 104 : 0);
        if (L >= ntot) return false;
        if (L < nlat) pg8::tile_of(L, 64, 26, u.pm, u.pn);
        else { const int j = L - nlat; u.pm = 64 + j / 26; u.pn = j % 26; }
        u.k0 = 0; u.nt = 16; u.tag = 0; return true;
    }
};
struct SchedV {
    int idx, nv;
    __device__ __forceinline__ bool next(int i, Unit& u) const {
        if (i > 0 || idx < 0 || idx >= nv) return false;
        u.pm = idx >> 1; u.pn = 4 + (idx & 1); u.k0 = 0; u.nt = 16; u.tag = 0; return true;
    }
};
struct SchedTile {
    int pm, pn, chain;
    __device__ __forceinline__ bool next(int i, Unit& u) const {
        if (i >= (chain ? 3 : 1)) return false;
        u.pm = pm; u.pn = pn;
        if (chain) { u.k0 = i == 0 ? 0 : (i == 1 ? 512 : 768); u.nt = i == 0 ? 8 : 4; u.tag = i; u.amode = (i == 1 && pm < 64) ? 1 : 0; } else { u.k0 = 0; u.nt = 16; u.tag = 0; u.amode = 0; }
        return true;
    }
};
struct SchedC1 {
    int G, c, ntiles;
    __device__ __forceinline__ bool next(int i, Unit& u) const {
        const int T = (i / 3) * G + c, seg = i % 3;
        if (T >= ntiles) return false;
        if (T < 256) pg8::tile_of(T, 64, 4, u.pm, u.pn); else { u.pm = 64 + ((T - 256) >> 2); u.pn = (T - 256) & 3; }
        u.k0 = seg == 0 ? 0 : (seg == 1 ? 512 : 768); u.nt = seg == 0 ? 8 : 4; u.tag = seg; return true;
    }
};
struct SchedC2 {
    int G, c, ntiles;
    __device__ __forceinline__ bool next(int i, Unit& u) const {
        const int T = i * G + c;
        if (T >= ntiles) return false;
        if (T < 256) pg8::tile_of(T, 64, 4, u.pm, u.pn); else { u.pm = 64 + ((T - 256) >> 2); u.pn = (T - 256) & 3; }
        u.k0 = 0; u.nt = 16; u.tag = 0; return true;
    }
};
struct SchedFc {
    int b;
    __device__ __forceinline__ bool next(int i, Unit& u) const { if (i > 0) return false; u.pm = 0; u.pn = b; u.k0 = 0; u.nt = 8; u.tag = 0; return true; }
};

struct EpiIn {
    unsigned char* wsb;
    __device__ __forceinline__ bool operator()(AccRef acc, const Unit& u, int wr, int wc, int fr, int fq) const {
        bf16* const Q = (bf16*)(wsb + WS_Q); bf16* const K = (bf16*)(wsb + WS_K); bf16* const VTL = (bf16*)(wsb + WS_VTL); bf16* const VTC = (bf16*)(wsb + WS_VTC); bf16* const GA = (bf16*)(wsb + WS_GA);
        bf16* const UFL = (bf16*)(wsb + WS_UFL); bf16* const ZT = (bf16*)(wsb + WS_ZT); bf16* const GF = (bf16*)(wsb + WS_GF); bf16* const GLU = (bf16*)(wsb + WS_GLU); bf16* const GC = (bf16*)(wsb + WS_GC); unsigned char* const S = wsb + WS_S;
        const int pn = u.pn, pm = u.pm;
        const int rl = wr * 64 + fr;
        const size_t row0 = (size_t)pm * 256 + rl;
        const int cl = wc * 32 + 8 * fq;
        if (pn == 10 && pm < 64) {
            const int b = pm >> 4;
#pragma unroll
            for (int ai = 0; ai < 2; ++ai)
#pragma unroll
                for (int m = 0; m < 4; ++m) { const int ntok = (pm & 15) * 256 + ai * 128 + m * 16 + rl;
#pragma unroll
                    for (int bj = 0; bj < 2; ++bj)
#pragma unroll
                        for (int n = 0; n < 2; ++n) { const int cb4 = (bj * 128 + cl) / 4 + n; f32x4 v = acc[ai][bj][m][n];
#pragma unroll
                            for (int e = 0; e < 4; ++e) v[e] = fast_silu(v[e]);
                            *(u32x2*)(GF + ((size_t)(b * 64 + cb4) * 4096 + ntok) * 4) = (u32x2){cvt_pk_bf16(v[0], v[1]), cvt_pk_bf16(v[2], v[3])}; } }
        } else if (pn < 4 || (pn >= 6 && pn < 8) || pn == 10 || pn == 13) {
            bf16* base; int ldc, col0; int act;
            if (pn < 2) { base = Q; ldc = 512; col0 = pn * 256; act = 1; }
            else if (pn < 4) { base = K; ldc = 512; col0 = (pn - 2) * 256; act = 0; }
            else if (pn < 8) { base = GA; ldc = 512; col0 = (pn - 6) * 256; act = 2; }
            else if (pn == 10) { base = GF; ldc = 256; col0 = 0; act = 2; }
            else { base = GC; ldc = 256; col0 = 0; act = 2; }
#pragma unroll
            for (int ai = 0; ai < 2; ++ai)
#pragma unroll
                for (int m = 0; m < 4; ++m) { bf16* rp = base + (row0 + ai * 128 + m * 16) * ldc + col0 + cl;
#pragma unroll
                    for (int bj = 0; bj < 2; ++bj) { f32x4 v0 = acc[ai][bj][m][0], v1 = acc[ai][bj][m][1];
                        if (act == 1) { v0 = v0 * QSCALE; v1 = v1 * QSCALE; }
                        if (act == 2) {
#pragma unroll
                            for (int e = 0; e < 4; ++e) { v0[e] = fast_silu(v0[e]); v1[e] = fast_silu(v1[e]); } }
                        u32x4 w; w.x = cvt_pk_bf16(v0[0], v0[1]); w.y = cvt_pk_bf16(v0[2], v0[3]); w.z = cvt_pk_bf16(v1[0], v1[1]); w.w = cvt_pk_bf16(v1[2], v1[3]);
                        *(u32x4*)(rp + bj * 128) = w; } }
        } else if (pn < 6) {
#pragma unroll
            for (int ai = 0; ai < 2; ++ai)
#pragma unroll
                for (int m = 0; m < 4; ++m) { const int t = ai * 128 + m * 16 + rl;
                    bf16* tb; size_t ts;
                    if (pm < 64) { tb = VTL + (size_t)(pm >> 4) * 8 * 64 * 4096 + (pm & 15) * 256 + t; ts = 4096; } else { tb = VTC + (size_t)(pm - 64) * 8 * 64 * 256 + t; ts = 256; }
#pragma unroll
                    for (int bj = 0; bj < 2; ++bj)
#pragma unroll
                        for (int n = 0; n < 2; ++n)
#pragma unroll
                            for (int e = 0; e < 4; ++e) { const int vcol = (pn - 4) * 256 + bj * 128 + cl + 4 * n + e;
                                tb[(size_t)vcol * ts] = (bf16)f2bf(acc[ai][bj][m][n][e]); } }
        } else if (pn < 10) {
            const int ri = pn - 8;
#pragma unroll
            for (int ai = 0; ai < 2; ++ai)
#pragma unroll
                for (int m = 0; m < 4; ++m) { const int t = ai * 128 + m * 16 + rl;
                    if (pm < 64) { const int b = pm >> 4, ntok = (pm & 15) * 256 + t;
#pragma unroll
                        for (int bj = 0; bj < 2; ++bj)
#pragma unroll
                            for (int n = 0; n < 2; ++n) { const int cb4 = (bj * 128 + cl) / 4 + n; const f32x4 v = acc[ai][bj][m][n];
                                u32x2 w; w.x = cvt_pk_bf16(v[0], v[1]); w.y = cvt_pk_bf16(v[2], v[3]);
                                *(u32x2*)(UFL + ((size_t)((b * 2 + ri) * 64 + cb4) * 4096 + ntok) * 4) = w; }
                    } else { const int b = pm - 64;
#pragma unroll
                        for (int bj = 0; bj < 2; ++bj)
#pragma unroll
                            for (int n = 0; n < 2; ++n)
#pragma unroll
                                for (int e = 0; e < 4; ++e) { const int ch = bj * 128 + cl + 4 * n + e;
                                    ZT[((size_t)(b * 256 + ch) * 2 + ri) * 256 + t] = (bf16)f2bf(acc[ai][bj][m][n][e]); } } }
        } else if (pn < 13) {
            const int col0 = (pn - 11) * 128 + cl;
#pragma unroll
            for (int ai = 0; ai < 2; ++ai)
#pragma unroll
                for (int m = 0; m < 4; ++m) { f32x4 a0 = acc[ai][0][m][0], a1 = acc[ai][0][m][1]; const f32x4 b0 = acc[ai][1][m][0], b1 = acc[ai][1][m][1];
#pragma unroll
                    for (int e = 0; e < 4; ++e) { a0[e] *= fast_sigmoid(b0[e]); a1[e] *= fast_sigmoid(b1[e]); }
                    u32x4 w; w.x = cvt_pk_bf16(a0[0], a0[1]); w.y = cvt_pk_bf16(a0[2], a0[3]); w.z = cvt_pk_bf16(a1[0], a1[1]); w.w = cvt_pk_bf16(a1[2], a1[3]);
                    *(u32x4*)(GLU + (row0 + ai * 128 + m * 16) * 256 + col0) = w; }
        } else {
            const int g = (pn - 14) >> 2, pl = (pn - 14) & 3;
            unsigned char* sb = S + (size_t)g * MT * 1024 + pl * 256 + 64 * wc + 16 * fq;
#pragma unroll
            for (int ai = 0; ai < 2; ++ai)
#pragma unroll
                for (int m = 0; m < 4; ++m) { unsigned w[4];
#pragma unroll
                    for (int bj = 0; bj < 2; ++bj)
#pragma unroll
                        for (int n = 0; n < 2; ++n) { const f32x4 v = acc[ai][bj][m][n]; unsigned p = 0;
                            typedef float f32x2 __attribute__((ext_vector_type(2)));
#pragma unroll
                            for (int e2 = 0; e2 < 2; ++e2) {
                                f32x2 t = (f32x2){v[2 * e2], v[2 * e2 + 1]} * (f32x2){-LOG2E, -LOG2E};
                                t = (f32x2){__builtin_amdgcn_exp2f(t.x), __builtin_amdgcn_exp2f(t.y)} + (f32x2){1.f, 1.f};
                                t = (f32x2){__builtin_amdgcn_rcpf(t.x), __builtin_amdgcn_rcpf(t.y)} * (f32x2){255.f, 255.f} + (f32x2){0.5f, 0.5f};
                                const unsigned q0 = (unsigned)fmaxf(t.x, 1.f), q1 = (unsigned)fmaxf(t.y, 1.f);
                                p |= (q0 << (16 * e2)) | (q1 << (16 * e2 + 8)); }
                            w[bj * 2 + n] = p; }
                    *(u32x4*)(sb + (row0 + ai * 128 + m * 16) * 1024) = (u32x4){w[0], w[1], w[2], w[3]}; }
        }
        return false;
    }
};
struct EpiV {
    unsigned char* wsb;
    __device__ __forceinline__ bool operator()(AccRef acc, const Unit& u, int wr, int wc, int fr, int fq) const {
        const int pm = u.pm, pn = u.pn;
        bf16* tb; unsigned ts;
        if (pm < 64) { tb = (bf16*)(wsb + WS_VTL) + (size_t)(pm >> 4) * 8 * 64 * 4096 + (pm & 15) * 256; ts = 4096; } else { tb = (bf16*)(wsb + WS_VTC) + (size_t)(pm - 64) * 8 * 64 * 256; ts = 256; }
#pragma unroll
        for (int bj = 0; bj < 2; ++bj)
#pragma unroll
            for (int n = 0; n < 2; ++n) { const int vcol = (pn - 4) * 256 + bj * 128 + wc * 32 + pg8::perm32(16 * n + fr);
                bf16* cp = tb + (size_t)vcol * ts + wr * 64 + 4 * fq;
#pragma unroll
                for (int ai = 0; ai < 2; ++ai)
#pragma unroll
                    for (int m = 0; m < 4; ++m) { const f32x4 v = acc[ai][bj][m][n];
                        *(u32x2*)(cp + ai * 128 + m * 16) = (u32x2){cvt_pk_bf16(v[0], v[1]), cvt_pk_bf16(v[2], v[3])}; } }
        return false;
    }
};
struct EpiC1 {
    bf16* MG; const unsigned char* S;
    __device__ __forceinline__ bool operator()(AccRef acc, const Unit& u, int wr, int wc, int fr, int fq) const {
        const int seg = u.tag; const bool mid = seg < 2;
        const unsigned row0 = (unsigned)(u.pm * 256 + wr * 64 + fr);
        const unsigned char* sb = S + (size_t)seg * MT * 1024 + u.pn * 256 + 64 * wc + 16 * fq;
        const unsigned char* sn = mid ? sb + (size_t)MT * 1024 : sb;
#pragma unroll
        for (int ai = 0; ai < 2; ++ai) {
            u32x4 sv[4], nv[4];
#pragma unroll
            for (int m = 0; m < 4; ++m) { const unsigned off = (row0 + (unsigned)(ai * 128 + m * 16)) * 1024u; sv[m] = *(const u32x4*)(sb + off); nv[m] = *(const u32x4*)(sn + off); }
#pragma unroll
            for (int m = 0; m < 4; ++m) { const u32x4 s4 = sv[m], n4 = mid ? nv[m] : (u32x4){~0u, ~0u, ~0u, ~0u};
#pragma unroll
                for (int bj = 0; bj < 2; ++bj) {
                    const unsigned g0 = bj == 0 ? s4.x : s4.z, g1 = bj == 0 ? s4.y : s4.w, h0 = bj == 0 ? n4.x : n4.z, h1 = bj == 0 ? n4.y : n4.w;
#pragma unroll
                    for (int e = 0; e < 4; ++e) {
                        const float q0 = (float)((g0 >> (8 * e)) & 255u), q1 = (float)((g1 >> (8 * e)) & 255u);
                        const float d0 = (float)((h0 >> (8 * e)) & 255u), d1 = (float)((h1 >> (8 * e)) & 255u);
                        acc[ai][bj][m][0][e] *= q0 * __builtin_amdgcn_rcpf(d0); acc[ai][bj][m][1][e] *= q1 * __builtin_amdgcn_rcpf(d1); } } }
            asm volatile("" ::: "memory"); }
        if (!mid) {
            bf16* mb = MG + u.pn * 256 + wc * 32 + 8 * fq;
#pragma unroll
            for (int ai = 0; ai < 2; ++ai)
#pragma unroll
                for (int m = 0; m < 4; ++m) { const unsigned off = (row0 + (unsigned)(ai * 128 + m * 16)) * 1024u;
#pragma unroll
                    for (int bj = 0; bj < 2; ++bj) { const f32x4 v0 = acc[ai][bj][m][0], v1 = acc[ai][bj][m][1];
                        u32x4 w; w.x = cvt_pk_bf16(v0[0], v0[1]); w.y = cvt_pk_bf16(v0[2], v0[3]); w.z = cvt_pk_bf16(v1[0], v1[1]); w.w = cvt_pk_bf16(v1[2], v1[3]);
                        *(u32x4*)(mb + (off + (unsigned)(bj * 128))) = w; } }
        }
        return mid;
    }
};
struct EpiC2 {
    bf16* Y; float* SSQ;
    __device__ __forceinline__ bool operator()(AccRef acc, const Unit& u, int wr, int wc, int fr, int fq) const {
        const size_t row0 = (size_t)u.pm * 256 + wr * 64 + fr;
        bf16* yb = Y + u.pn * 256 + wc * 32 + 8 * fq;
#pragma unroll
        for (int ai = 0; ai < 2; ++ai)
#pragma unroll
            for (int m = 0; m < 4; ++m) { const size_t row = row0 + ai * 128 + m * 16; float s = 0.f;
#pragma unroll
                for (int bj = 0; bj < 2; ++bj) { const f32x4 v0 = acc[ai][bj][m][0], v1 = acc[ai][bj][m][1];
                    s += (v0[0] * v0[0] + v0[1] * v0[1]) + (v0[2] * v0[2] + v0[3] * v0[3]) + (v1[0] * v1[0] + v1[1] * v1[1]) + (v1[2] * v1[2] + v1[3] * v1[3]);
                    u32x4 w; w.x = cvt_pk_bf16(v0[0], v0[1]); w.y = cvt_pk_bf16(v0[2], v0[3]); w.z = cvt_pk_bf16(v1[0], v1[1]); w.w = cvt_pk_bf16(v1[2], v1[3]);
                    *(u32x4*)(yb + row * 1024 + bj * 128) = w; }
                s += __shfl_xor(s, 16); s += __shfl_xor(s, 32);
                if (fq == 0) SSQ[row * 16 + u.pn * 4 + wc] = s; }
        return false;
    }
};
struct EpiFc {
    bf16* ACAT; const bf16* GF;
    __device__ __forceinline__ bool operator()(AccRef acc, const Unit& u, int wr, int wc, int fr, int fq) const {
        const size_t row0 = (size_t)ML + u.pn * 256 + wr * 64 + fr; const int cl = wc * 32 + 8 * fq;
#pragma unroll
        for (int ai = 0; ai < 2; ++ai) {
            u32x4 gqv[4][2];
#pragma unroll
            for (int m = 0; m < 4; ++m)
#pragma unroll
                for (int bj = 0; bj < 2; ++bj) gqv[m][bj] = *(const u32x4*)(GF + (row0 + ai * 128 + m * 16) * 256 + bj * 128 + cl);
            asm volatile("" ::: "memory");
#pragma unroll
            for (int m = 0; m < 4; ++m) { const size_t row = row0 + ai * 128 + m * 16;
#pragma unroll
                for (int bj = 0; bj < 2; ++bj) { f32x4 v0 = acc[ai][bj][m][0], v1 = acc[ai][bj][m][1];
                    const u32x4 gq = gqv[m][bj];
                    v0[0] *= bflo(gq.x); v0[1] *= bfhi(gq.x); v0[2] *= bflo(gq.y); v0[3] *= bfhi(gq.y); v1[0] *= bflo(gq.z); v1[1] *= bfhi(gq.z); v1[2] *= bflo(gq.w); v1[3] *= bfhi(gq.w);
                    u32x4 w; w.x = cvt_pk_bf16(v0[0], v0[1]); w.y = cvt_pk_bf16(v0[2], v0[3]); w.z = cvt_pk_bf16(v1[0], v1[1]); w.w = cvt_pk_bf16(v1[2], v1[3]);
                    *(u32x4*)(ACAT + row * 1024 + 512 + bj * 128 + cl) = w; } } }
        return false;
    }
};

constexpr int AT_KS = 72, AT_VS = 68;
constexpr int AT_KOFF = 0, AT_VOFF = 4 * 64 * AT_KS * 2, AT_BOFF = AT_VOFF + 4 * 64 * AT_VS * 2;
struct FourPre { u32x2 t4[4][4]; };
__device__ __forceinline__ void four_pre(Frame& F, int item, FourPre& P) {
    const int tid = F.tid, b = item >> 6, cb = item & 63;
    const bf16* UFL = WSP(bf16, WS_UFL);
#pragma unroll
    for (int q = 0; q < 4; ++q) { const int task = tid + 512 * q, n2 = task & 63, n1q = (task >> 6) & 15, ri = task >> 10;
        const bf16* src = UFL + ((size_t)((b * 2 + ri) * 64 + cb) * 4096 + (size_t)(256 * n1q + n2)) * 4;
#pragma unroll
        for (int i = 0; i < 4; ++i) P.t4[q][i] = *(const u32x2*)(src + (size_t)i * 64 * 4); }
}
struct AttnDesc { int b, h, R0, nwin, r, c0; size_t qbase; bool isctx; };
__device__ __forceinline__ AttnDesc attn_desc(Frame& F, int unit) {
    AttnDesc d; const int w = F.wave;
    d.isctx = unit >= 512; d.R0 = 0; d.nwin = 0; d.r = 0; d.c0 = 0;
    if (!d.isctx) { d.b = unit >> 7; d.h = (unit >> 4) & 7; const int rb = unit & 15; const int ra = 4 * rb;
        d.R0 = min(max(ra - 4, 0), 56); const int R1 = min(max(ra + 3 - 4, 0), 56) + 8; d.nwin = R1 - d.R0;
        d.r = ra + (w >> 1); d.c0 = 32 * (w & 1); d.qbase = (size_t)d.b * SEQ + d.r * 64 + d.c0; }
    else { const int j = unit - 512; d.b = j >> 3; d.h = j & 7; d.qbase = (size_t)ML + d.b * CTX + 32 * w; }
    return d;
}
struct AttnPre { bf16x8 qf[2][2]; u32x4 k0, v0, k1, v1; float bias; };
__device__ __forceinline__ void attn_pre(Frame& F, int unit, int layer, AttnPre& P) {
    const AttnDesc d = attn_desc(F, unit); const int tid = F.tid, fr = F.lane & 15, fq = F.lane >> 4, srow = tid >> 3, sch = tid & 7;
#pragma unroll
    for (int g = 0; g < 2; ++g)
#pragma unroll
        for (int ks = 0; ks < 2; ++ks) P.qf[g][ks] = *(const bf16x8*)(WSP(bf16, WS_Q) + (d.qbase + 16 * g + fr) * 512 + d.h * 64 + 32 * ks + 8 * fq);
    const bf16* vtl = WSP(bf16, WS_VTL) + ((size_t)(d.b * 8 + d.h) * 64 + srow) * 4096 + sch * 8;
    const bf16* vtc = WSP(bf16, WS_VTC) + ((size_t)(d.b * 8 + d.h) * 64 + srow) * 256 + sch * 8;
    const bf16* Kp = WSP(bf16, WS_K);
#pragma unroll
    for (int t = 0; t < 2; ++t) { size_t ktok; const bf16* vp;
        if (t < d.nwin) { ktok = (size_t)d.b * SEQ + (size_t)(d.R0 + t) * 64; vp = vtl + (d.R0 + t) * 64; } else { ktok = (size_t)ML + d.b * CTX + (t - d.nwin) * 64; vp = vtc + (t - d.nwin) * 64; }
        const u32x4 kk = *(const u32x4*)(Kp + (ktok + srow) * 512 + d.h * 64 + sch * 8), vv = *(const u32x4*)vp;
        if (t == 0) { P.k0 = kk; P.v0 = vv; } else { P.k1 = kk; P.v1 = vv; } }
    P.bias = (!d.isctx && tid < 465) ? F_rpb[((size_t)layer * NH + d.h) * 465 + tid] * LOG2E : 0.f;
}
template <bool FOURPF>
__device__ __forceinline__ void attn_unit(Frame& F, int unit, int layer, const AttnPre& P, int next_unit, AttnPre& NP, int four_next, FourPre& FP) {
    const int tid = F.tid, lane = F.lane, w = F.wave, fr = lane & 15, fq = lane >> 4;
    const bf16* Qp = WSP(bf16, WS_Q); const bf16* Kp = WSP(bf16, WS_K); const bf16* GA = WSP(bf16, WS_GA); bf16* ACAT = WSP(bf16, WS_XN);
    const AttnDesc dd = attn_desc(F, unit);
    const bool isctx = dd.isctx; const int b = dd.b, h = dd.h, R0 = dd.R0, nwin = dd.nwin, r = dd.r, c0 = dd.c0; const size_t qbase = dd.qbase;
    const int myrs = isctx ? 0 : (min(max(r - 4, 0), 56) - R0);
    const int nt = nwin + 4;
    LAS float* btab = (LAS float*)(F.lds + AT_BOFF);
    if (!isctx && tid < 465) btab[64 + tid] = P.bias;
    bf16x8 qf[2][2];
#pragma unroll
    for (int g = 0; g < 2; ++g)
#pragma unroll
        for (int ks = 0; ks < 2; ++ks) qf[g][ks] = P.qf[g][ks];
    const int srow = tid >> 3, sch = tid & 7;
    const bf16* vtl = WSP(bf16, WS_VTL) + ((size_t)(b * 8 + h) * 64 + srow) * 4096 + sch * 8;
    const bf16* vtc = WSP(bf16, WS_VTC) + ((size_t)(b * 8 + h) * 64 + srow) * 256 + sch * 8;
    u32x4 kA = P.k0, vA = P.v0, kB = P.k1, vB = P.v1;
#define AT_LOAD(t, kreg, vreg) do { const int _t = (t); size_t ktok; const bf16* vp; \
        if (_t < nwin) { ktok = (size_t)b * SEQ + (size_t)(R0 + _t) * 64; vp = vtl + (R0 + _t) * 64; } else { ktok = (size_t)ML + b * CTX + (_t - nwin) * 64; vp = vtc + (_t - nwin) * 64; } \
        kreg = *(const u32x4*)(Kp + (ktok + srow) * 512 + h * 64 + sch * 8); vreg = *(const u32x4*)vp; } while (0)
#define AT_WRITE(buf, kreg, vreg) do { *(LAS u32x4*)(F.lds + AT_KOFF + (buf) * 64 * AT_KS * 2 + (srow * AT_KS + sch * 8) * 2) = kreg; \
        LAS u32x2* _v = (LAS u32x2*)(F.lds + AT_VOFF + (buf) * 64 * AT_VS * 2 + (srow * AT_VS + sch * 8) * 2); _v[0] = (u32x2){vreg.x, vreg.y}; _v[1] = (u32x2){vreg.z, vreg.w}; } while (0)
    AT_WRITE(0, kA, vA); AT_WRITE(1, kB, vB);
    __syncthreads();
    f32x4 O[2][4];
#pragma unroll
    for (int g = 0; g < 2; ++g)
#pragma unroll
        for (int dt = 0; dt < 4; ++dt) O[g][dt] = (f32x4){0.f, 0.f, 0.f, 0.f};
    float lrun[2] = {0.f, 0.f};
    const unsigned koffl = (unsigned)((fr * AT_KS + 8 * fq) * 2), voffl = (unsigned)((fr * AT_VS + 4 * fq) * 2);
#define AT_VLOAD(vf, vad) do { _Pragma("unroll") for (int dt = 0; dt < 4; ++dt) { \
            const u32x2 v0 = *(const LAS u32x2*)(F.lds + (vad) + (16 * dt * AT_VS) * 2), v1 = *(const LAS u32x2*)(F.lds + (vad) + (16 * dt * AT_VS + 16) * 2); \
            (vf)[dt] = __builtin_bit_cast(bf16x8, (u32x4){v0.x, v0.y, v1.x, v1.y}); } } while (0)
#define AT_PVC(g, plo, phi, vf) do { \
        u32x4 pw; pw.x = cvt_pk_bf16((plo)[0], (plo)[1]); pw.y = cvt_pk_bf16((plo)[2], (plo)[3]); pw.z = cvt_pk_bf16((phi)[0], (phi)[1]); pw.w = cvt_pk_bf16((phi)[2], (phi)[3]); \
        const bf16x8 pf = __builtin_bit_cast(bf16x8, pw); \
        _Pragma("unroll") for (int dt = 0; dt < 4; ++dt) O[g][dt] = __builtin_amdgcn_mfma_f32_16x16x32_bf16((vf)[dt], pf, O[g][dt], 0, 0, 0); } while (0)
#define AT_COMPUTE(tt, bufi) do { const int t = (tt); const bool win = t < nwin; \
        if (!win || (t >= myrs && t < myrs + 8)) { \
            const unsigned kad = (unsigned)(AT_KOFF + (bufi) * 64 * AT_KS * 2) + koffl, vad = (unsigned)(AT_VOFF + (bufi) * 64 * AT_VS * 2) + voffl; \
            if (win) { const int dr = (R0 + t) - r + 7; \
                _Pragma("unroll") for (int g = 0; g < 2; ++g) { \
                    const int g0 = c0 + 16 * g, ksg = min(max(g0 - 8, 0), 32), qc = g0 + fr, cs = min(max(qc - 8, 0), 48); \
                    const LAS float* bp = btab + 64 + dr * 31 + 15 - qc + ksg + 4 * fq; const int lo = ksg + 4 * fq - cs; \
                    const unsigned kadg = kad + (unsigned)(ksg * AT_KS * 2), vadg = vad + (unsigned)(ksg * 2); \
                    bf16x8 ka[2][2], vf[4]; float bv[2][4]; \
                    _Pragma("unroll") for (int kt = 0; kt < 2; ++kt) _Pragma("unroll") for (int e = 0; e < 4; ++e) bv[kt][e] = bp[16 * kt + e]; \
                    _Pragma("unroll") for (int ks = 0; ks < 2; ++ks) _Pragma("unroll") for (int kt = 0; kt < 2; ++kt) ka[kt][ks] = *(const LAS bf16x8*)(F.lds + kadg + (16 * kt * AT_KS + 32 * ks) * 2); \
                    AT_VLOAD(vf, vadg); \
                    f32x4 s[2]; \
                    _Pragma("unroll") for (int kt = 0; kt < 2; ++kt) _Pragma("unroll") for (int e = 0; e < 4; ++e) s[kt][e] = ((unsigned)(16 * kt + e + lo) < 16u) ? bv[kt][e] : -1e30f; \
                    _Pragma("unroll") for (int ks = 0; ks < 2; ++ks) _Pragma("unroll") for (int kt = 0; kt < 2; ++kt) s[kt] = __builtin_amdgcn_mfma_f32_16x16x32_bf16(ka[kt][ks], qf[g][ks], s[kt], 0, 0, 0); \
                    float ls = 0.f; \
                    _Pragma("unroll") for (int kt = 0; kt < 2; ++kt) _Pragma("unroll") for (int e = 0; e < 4; ++e) { s[kt][e] = __builtin_amdgcn_exp2f(s[kt][e]); ls += s[kt][e]; } \
                    lrun[g] += ls; \
                    AT_PVC(g, s[0], s[1], vf); } \
                asm volatile("" ::: "memory"); \
            } else { \
                f32x4 sc[2][4]; \
                _Pragma("unroll") for (int g = 0; g < 2; ++g) _Pragma("unroll") for (int kt = 0; kt < 4; ++kt) sc[g][kt] = (f32x4){0.f, 0.f, 0.f, 0.f}; \
                bf16x8 ka[2][4], vfa[4], vfb[4]; \
                _Pragma("unroll") for (int ks = 0; ks < 2; ++ks) _Pragma("unroll") for (int kt = 0; kt < 4; ++kt) ka[ks][kt] = *(const LAS bf16x8*)(F.lds + kad + (16 * kt * AT_KS + 32 * ks) * 2); \
                AT_VLOAD(vfa, vad); AT_VLOAD(vfb, vad + 64u); \
                _Pragma("unroll") for (int ks = 0; ks < 2; ++ks) \
                    _Pragma("unroll") for (int g = 0; g < 2; ++g) _Pragma("unroll") for (int kt = 0; kt < 4; ++kt) sc[g][kt] = __builtin_amdgcn_mfma_f32_16x16x32_bf16(ka[ks][kt], qf[g][ks], sc[g][kt], 0, 0, 0); \
                _Pragma("unroll") for (int g = 0; g < 2; ++g) { \
                    float ls = 0.f; \
                    _Pragma("unroll") for (int kt = 0; kt < 4; ++kt) _Pragma("unroll") for (int e = 0; e < 4; ++e) { sc[g][kt][e] = __builtin_amdgcn_exp2f(sc[g][kt][e]); ls += sc[g][kt][e]; } \
                    lrun[g] += ls; \
                    AT_PVC(g, sc[g][0], sc[g][1], vfa); AT_PVC(g, sc[g][2], sc[g][3], vfb); } \
                asm volatile("" ::: "memory"); } } } while (0)
    for (int t0 = 0; t0 < nt; t0 += 2) {
        const int cb = (t0 & 2), nb = cb ^ 2;
        if (t0 + 2 < nt) AT_LOAD(t0 + 2, kA, vA);
        if (t0 + 3 < nt) AT_LOAD(t0 + 3, kB, vB);
        AT_COMPUTE(t0, cb);
        asm volatile("" ::: "memory");
        if (t0 + 1 < nt) AT_COMPUTE(t0 + 1, cb + 1);
        if (t0 + 2 < nt) AT_WRITE(nb, kA, vA);
        if (t0 + 3 < nt) AT_WRITE(nb + 1, kB, vB);
        __syncthreads();
    }
#undef AT_COMPUTE
#undef AT_PVC
#undef AT_VLOAD
#undef AT_LOAD
#undef AT_WRITE
    if constexpr (FOURPF) four_pre(F, four_next, FP); else attn_pre(F, next_unit, layer, NP);
    {
        u32x4 gqv[4];
#pragma unroll
        for (int i = 0; i < 4; ++i) { const int pidx = lane + 64 * i, q = pidx >> 3, c = pidx & 7; gqv[i] = *(const u32x4*)(GA + (qbase + q) * 512 + h * 64 + 8 * c); }
        LAS float* ow = (LAS float*)(F.lds + w * (32 * 68 * 4));
#pragma unroll
        for (int g = 0; g < 2; ++g) { float l = lrun[g]; l += __shfl_xor(l, 16); l += __shfl_xor(l, 32); const float inv = __builtin_amdgcn_rcpf(l);
#pragma unroll
            for (int dt = 0; dt < 4; ++dt) *(LAS f32x4*)(ow + (16 * g + fr) * 68 + 16 * dt + 4 * fq) = O[g][dt] * inv; }
#pragma unroll
        for (int i = 0; i < 4; ++i) { const int pidx = lane + 64 * i, q = pidx >> 3, c = pidx & 7;
            const f32x4 a = *(const LAS f32x4*)(ow + q * 68 + 8 * c), bq = *(const LAS f32x4*)(ow + q * 68 + 8 * c + 4);
            const u32x4 gq = gqv[i];
            u32x4 o; o.x = cvt_pk_bf16(a[0] * bflo(gq.x), a[1] * bfhi(gq.x)); o.y = cvt_pk_bf16(a[2] * bflo(gq.y), a[3] * bfhi(gq.y));
            o.z = cvt_pk_bf16(bq[0] * bflo(gq.z), bq[1] * bfhi(gq.z)); o.w = cvt_pk_bf16(bq[2] * bflo(gq.w), bq[3] * bfhi(gq.w));
            *(u32x4*)(ACAT + (qbase + q) * 1024 + h * 64 + 8 * c) = o; }
    }
    __syncthreads();
}

constexpr int FS = 144;
__device__ __forceinline__ void four_item(Frame& F, int item, const FourPre& FP) {
    const int tid = F.tid, lane = F.lane, w = F.wave, fr = lane & 15, fq = lane >> 4;
    const int b = item >> 6, cb = item & 63;
    LAS bf16* zT = (LAS bf16*)F.lds;
    LAS bf16* ZP = (LAS bf16*)(F.lds + 256 * FS * 2);
    const bf16* UFL = WSP(bf16, WS_UFL);
#pragma unroll
    for (int q = 0; q < 4; ++q) { const int task = tid + 512 * q, n2 = task & 63, n1q = (task >> 6) & 15, ri = task >> 10;
        u32x2 t4[4];
#pragma unroll
        for (int i = 0; i < 4; ++i) t4[i] = FP.t4[q][i];
#pragma unroll
        for (int ch = 0; ch < 4; ++ch) { unsigned e[4];
#pragma unroll
            for (int i = 0; i < 4; ++i) { const unsigned wd = (ch < 2) ? t4[i].x : t4[i].y; e[i] = (ch & 1) ? (wd >> 16) : (wd & 0xffffu); }
            *(LAS u32x2*)(zT + (ch * 64 + n2) * FS + ri * 64 + 4 * n1q) = (u32x2){e[0] | (e[1] << 16), e[2] | (e[3] << 16)}; } }
    const int t = w & 3, mh = w >> 2;
    const int k1 = 16 * t + fr, k2 = 16 * t + fr;
    bf16x8 bre[4], bim[4], bfv[4]; f32x4 tw0[8], tw1[8]; u32x2 gq[8];
    const bf16* GFb = WSP(bf16, WS_GF) + (size_t)(b * 64 + cb) * 4096 * 4;
    {
        const bf16* D1t = WSP(bf16, WS_D1T); const bf16* E2t = WSP(bf16, WS_E2T); const float* TW = WSP(float, WS_TW);
#pragma unroll
        for (int ks = 0; ks < 4; ++ks) { bre[ks] = *(const bf16x8*)(D1t + (16 * t + fr) * 128 + 32 * ks + 8 * fq); bim[ks] = *(const bf16x8*)(D1t + (16 * (t + 4) + fr) * 128 + 32 * ks + 8 * fq); }
#pragma unroll
        for (int mt = 0; mt < 8; ++mt) { const int M0 = 128 * mh + 16 * mt + 4 * fq, n2b = M0 & 63;
            tw0[mt] = *(const f32x4*)(TW + (size_t)(k1 * 64 + n2b) * 2); tw1[mt] = *(const f32x4*)(TW + (size_t)(k1 * 64 + n2b) * 2 + 4); }
#pragma unroll
        for (int ks = 0; ks < 4; ++ks) bfv[ks] = *(const bf16x8*)(E2t + (16 * t + fr) * 128 + 32 * ks + 8 * fq);
#pragma unroll
        for (int i = 0; i < 8; ++i) gq[i] = *(const u32x2*)(GFb + (size_t)(tid + 512 * i) * 4);
    }
    __syncthreads();
    {
#pragma unroll
        for (int mt = 0; mt < 8; ++mt) {
            const int M0 = 128 * mh + 16 * mt + 4 * fq, ch = M0 >> 6, n2b = M0 & 63;
            const f32x4 t0 = tw0[mt], t1 = tw1[mt];
            bf16x8 af[4];
#pragma unroll
            for (int ks = 0; ks < 4; ++ks) af[ks] = *(const LAS bf16x8*)(zT + (128 * mh + 16 * mt + fr) * FS + 32 * ks + 8 * fq);
            f32x4 zr = (f32x4){0.f, 0.f, 0.f, 0.f}, zi = (f32x4){0.f, 0.f, 0.f, 0.f};
#pragma unroll
            for (int ks = 0; ks < 4; ++ks) { zr = __builtin_amdgcn_mfma_f32_16x16x32_bf16(af[ks], bre[ks], zr, 0, 0, 0); zi = __builtin_amdgcn_mfma_f32_16x16x32_bf16(af[ks], bim[ks], zi, 0, 0, 0); }
            const float ct[4] = {t0.x, t0.z, t1.x, t1.z}, st[4] = {t0.y, t0.w, t1.y, t1.w};
            float pr[4], pi[4];
#pragma unroll
            for (int e = 0; e < 4; ++e) { pr[e] = zr[e] * ct[e] + zi[e] * st[e]; pi[e] = zi[e] * ct[e] - zr[e] * st[e]; }
            *(LAS u32x2*)(ZP + (k1 * 4 + ch) * FS + n2b) = (u32x2){cvt_pk_bf16(pr[0], pr[1]), cvt_pk_bf16(pr[2], pr[3])};
            *(LAS u32x2*)(ZP + (k1 * 4 + ch) * FS + 64 + n2b) = (u32x2){cvt_pk_bf16(pi[0], pi[1]), cvt_pk_bf16(pi[2], pi[3])};
        }
    }
    __syncthreads();
    LAS float* oimg = (LAS float*)F.lds;
    {
#pragma unroll
        for (int mt = 0; mt < 8; ++mt) {
            bf16x8 af[4];
#pragma unroll
            for (int ks = 0; ks < 4; ++ks) af[ks] = *(const LAS bf16x8*)(ZP + (128 * mh + 16 * mt + fr) * FS + 32 * ks + 8 * fq);
            f32x4 acc = (f32x4){0.f, 0.f, 0.f, 0.f};
#pragma unroll
            for (int ks = 0; ks < 4; ++ks) acc = __builtin_amdgcn_mfma_f32_16x16x32_bf16(af[ks], bfv[ks], acc, 0, 0, 0);
            const int k1o = (128 * mh + 16 * mt + 4 * fq) >> 2, n = k1o + 64 * k2;
            *(LAS f32x4*)(oimg + (n + (n >> 6)) * 4) = acc;
        }
    }
    __syncthreads();
    {
        bf16* AFb = WSP(bf16, WS_AFL) + (size_t)(b * 32 + (cb >> 1)) * 4096 * 8 + (cb & 1) * 4;
#pragma unroll
        for (int i = 0; i < 8; ++i) { const int n = tid + 512 * i; const f32x4 v = *(const LAS f32x4*)(oimg + (n + (n >> 6)) * 4);
            *(u32x2*)(AFb + (size_t)n * 8) = (u32x2){cvt_pk_bf16(v[0] * bflo(gq[i].x), v[1] * bfhi(gq[i].x)), cvt_pk_bf16(v[2] * bflo(gq[i].y), v[3] * bfhi(gq[i].y))}; }
    }
    __syncthreads();
}

constexpr int CV_GOFF = 0, CV_UOFF = 49152, CV_AS = 272, CV_US = 260;
__device__ __forceinline__ void conv_item(Frame& F, int item, int layer) {
#if defined(TS_MCONV)
#define CONV_MARK(k) do { if (TS_MCONV == (k) && item < 256 && layer == 1) TS_MARK(k); } while (0)
#else
#define CONV_MARK(k) do { } while (0)
#endif
    CONV_MARK(80);
    const int tid = F.tid, lane = F.lane, w = F.wave, fr = lane & 15, fq = lane >> 4;
    size_t row0; int lo, hi;
    if (item < 256) { const int b = item >> 6; row0 = (size_t)b * SEQ + (item & 63) * 64; lo = b * SEQ; hi = lo + SEQ; }
    else { const int j = item - 256, b = j >> 2; row0 = (size_t)ML + b * CTX + (j & 3) * 64; lo = ML + b * CTX; hi = lo + CTX; }
    const bf16* GLU = WSP(bf16, WS_GLU);
    LAS bf16* gt = (LAS bf16*)(F.lds + CV_GOFF);
    LAS float* U = (LAS float*)(F.lds + CV_UOFF);
    float wk[31]; float bias; bf16x8 bfv[8][2]; u32x4 gq[4];
    {
        u32x4 gv[6];
#pragma unroll
        for (int q = 0; q < 6; ++q) { const int i = tid + 512 * q, rr = i >> 5, ch = i & 31; const long grow = (long)row0 - 15 + rr;
            const bool ok = (i < 94 * 32) && grow >= lo && grow < hi;
            gv[q] = *(const u32x4*)(GLU + (size_t)(ok ? grow : (long)row0) * 256 + ch * 8);
            if (!ok) gv[q] = (u32x4){0u, 0u, 0u, 0u}; }
        {
            const int c = tid & 255;
#pragma unroll
            for (int t = 0; t < 31; ++t) wk[t] = F_cdw[((size_t)layer * 31 + t) * 256 + c];
            bias = F_cdb[layer * 256 + c];
            const bf16* GC = WSP(bf16, WS_GC);
#pragma unroll
            for (int i = 0; i < 4; ++i) { const int pidx = tid + 512 * i, tok = pidx >> 5, c8 = pidx & 31; gq[i] = *(const u32x4*)(GC + (row0 + tok) * 256 + 8 * c8); }
        }
#pragma unroll
        for (int q = 0; q < 6; ++q) { const int i = tid + 512 * q; if (i < 94 * 32) *(LAS u32x4*)(gt + (i >> 5) * 256 + (i & 31) * 8) = gv[q]; }
    }
    __syncthreads();
    CONV_MARK(81);
    {
        const int c = tid & 255, th = tid >> 8;
        typedef float f32x2 __attribute__((ext_vector_type(2)));
        f32x2 PE[16], PO[16];
#pragma unroll
        for (int i = 0; i < 16; ++i) { const int k0 = 2 * i, k1 = 2 * i + 1, k2 = 2 * i + 2;
            const float w0 = (k0 >= 1 && k0 <= 31) ? wk[31 - k0] : 0.f, w1 = (k1 >= 1 && k1 <= 31) ? wk[31 - k1] : 0.f, w2 = (k2 >= 1 && k2 <= 31) ? wk[31 - k2] : 0.f;
            PE[i] = (f32x2){w0, w1}; PO[i] = (f32x2){w1, w2}; }
#pragma unroll 1
        for (int q = 0; q < 4; ++q) {
            f32x2 a2[4];
#pragma unroll
            for (int pp = 0; pp < 4; ++pp) a2[pp] = (f32x2){bias, bias};
            const LAS bf16* gp = gt + (32 * th + 8 * q) * 256 + c; bf16 xs[38];
#pragma unroll
            for (int j = 0; j < 38; ++j) xs[j] = gp[j * 256];
            asm volatile("" ::: "memory");
#pragma unroll
            for (int j = 0; j < 38; ++j) { const float xv = bf2f(xs[j]); const f32x2 x2 = (f32x2){xv, xv};
#pragma unroll
                for (int pp = 0; pp < 4; ++pp) { const int Q = 31 - j + 2 * pp;
                    if (Q >= 0 && Q <= 31) a2[pp] += ((Q & 1) ? PO[(Q - 1) >> 1] : PE[Q >> 1]) * x2; } }
#pragma unroll
            for (int pp = 0; pp < 4; ++pp) { U[(32 * th + 8 * q + 2 * pp) * CV_US + c] = a2[pp].x; U[(32 * th + 8 * q + 2 * pp + 1) * CV_US + c] = a2[pp].y; }
        }
    }
    __syncthreads();
    CONV_MARK(82);
    {
        LAS bf16* At = (LAS bf16*)(F.lds + CV_GOFF);
        {   const bf16* Bt = WSP(bf16, WS_BTPW) + (size_t)layer * 65536;
#pragma unroll
            for (int ks = 0; ks < 8; ++ks)
#pragma unroll
                for (int n = 0; n < 2; ++n) bfv[ks][n] = *(const bf16x8*)(Bt + (size_t)(32 * w + 16 * n + fr) * 256 + 32 * ks + 8 * fq); }
        const f32x4 g = *(const f32x4*)(F_lng + layer * 256 + 4 * lane), bb = *(const f32x4*)(F_lnb + layer * 256 + 4 * lane);
        f32x4 v8[8]; float r8[8];
#pragma unroll
        for (int i = 0; i < 8; ++i) { v8[i] = *(const LAS f32x4*)(U + (8 * w + i) * CV_US + 4 * lane); r8[i] = (v8[i].x + v8[i].y) + (v8[i].z + v8[i].w); }
        wave_sum8(r8);
#pragma unroll
        for (int i = 0; i < 8; ++i) { v8[i] = v8[i] - r8[i] * (1.f / 256.f); r8[i] = (v8[i].x * v8[i].x + v8[i].y * v8[i].y) + (v8[i].z * v8[i].z + v8[i].w * v8[i].w); }
        wave_sum8(r8);
#pragma unroll
        for (int i = 0; i < 8; ++i) { const int tok = 8 * w + i;
            const float rs = __builtin_amdgcn_rsqf(r8[i] * (1.f / 256.f) + EPS);
            f32x4 y = v8[i] * rs * g + bb;
#pragma unroll
            for (int e = 0; e < 4; ++e) y[e] = fast_silu(y[e]);
            *(LAS u32x2*)(At + tok * CV_AS + 4 * lane) = (u32x2){cvt_pk_bf16(y[0], y[1]), cvt_pk_bf16(y[2], y[3])}; }
    }
    __syncthreads();
    CONV_MARK(83);
    {
        const LAS bf16* At = (const LAS bf16*)(F.lds + CV_GOFF);
        f32x4 acc[4][2];
#pragma unroll
        for (int m = 0; m < 4; ++m)
#pragma unroll
            for (int n = 0; n < 2; ++n) acc[m][n] = (f32x4){0.f, 0.f, 0.f, 0.f};
#pragma unroll
        for (int ks = 0; ks < 8; ++ks) {
            bf16x8 af[4];
#pragma unroll
            for (int m = 0; m < 4; ++m) af[m] = *(const LAS bf16x8*)(At + (16 * m + fr) * CV_AS + 32 * ks + 8 * fq);
#pragma unroll
            for (int m = 0; m < 4; ++m)
#pragma unroll
                for (int n = 0; n < 2; ++n) acc[m][n] = __builtin_amdgcn_mfma_f32_16x16x32_bf16(bfv[ks][n], af[m], acc[m][n], 0, 0, 0);
        }
#pragma unroll
        for (int m = 0; m < 4; ++m)
#pragma unroll
            for (int n = 0; n < 2; ++n) *(LAS f32x4*)(U + (16 * m + fr) * CV_US + 32 * w + 16 * n + 4 * fq) = acc[m][n];
    }
    __syncthreads();
    CONV_MARK(84);
    {
        bf16* ACAT = WSP(bf16, WS_XN);
#pragma unroll
        for (int i = 0; i < 4; ++i) { const int pidx = tid + 512 * i, tok = pidx >> 5, c8 = pidx & 31;
            const f32x4 a = *(const LAS f32x4*)(U + tok * CV_US + 8 * c8), bq = *(const LAS f32x4*)(U + tok * CV_US + 8 * c8 + 4); const u32x4 g4 = gq[i];
            u32x4 o; o.x = cvt_pk_bf16(a[0] * bflo(g4.x), a[1] * bfhi(g4.x)); o.y = cvt_pk_bf16(a[2] * bflo(g4.y), a[3] * bfhi(g4.y));
            o.z = cvt_pk_bf16(bq[0] * bflo(g4.z), bq[1] * bfhi(g4.z)); o.w = cvt_pk_bf16(bq[2] * bflo(g4.w), bq[3] * bfhi(g4.w));
            *(u32x4*)(ACAT + (row0 + tok) * 1024 + 768 + 8 * c8) = o; }
    }
    CONV_MARK(85);
    __syncthreads();
}

__device__ __forceinline__ void panel_sync(unsigned* cnt, unsigned target) {
    asm volatile("s_waitcnt vmcnt(0)" ::: "memory");
    __syncthreads();
    if (threadIdx.x == 0) {
        __builtin_amdgcn_fence(__ATOMIC_RELEASE, "agent");
        asm volatile("s_waitcnt vmcnt(0)" ::: "memory");
        (void)xb_add(cnt, 1u);
        unsigned sp = 0;
        while (xb_ld(cnt) < target) { __builtin_amdgcn_s_sleep(1); if (++sp > (1u << 22)) break; }
        __builtin_amdgcn_fence(__ATOMIC_ACQUIRE, "agent");
        asm volatile("s_waitcnt vmcnt(0)" ::: "memory");
    }
    __syncthreads();
}
__device__ __forceinline__ void ctx_rows(Frame& F, int p, int q) {
    const int lane = F.lane;
    const bf16* YC = WSP(bf16, WS_YC); const float* SSQ = WSP(float, WS_SSQ); bf16* XN = WSP(bf16, WS_XN);
    for (int i = 0; i < 8; ++i) {
        const int cr = 256 * p + 64 * q + 8 * F.wave + i;
        Row16 xv, yv; ld_row_f32(F_ctx + (size_t)cr * D, lane, xv); ld_row_bf16(YC + (size_t)cr * D, lane, yv);
        const float sp = lane < 16 ? SSQ[(size_t)(ML + cr) * 16 + lane] : 0.f;
        const float rs = __builtin_amdgcn_rsqf(wave_sum(sp) * (1.f / D) + EPS);
        Row16 g2; ld_row_f32(WSP(float, WS_MODV) + ((size_t)0 * 5 + 4) * 3072 + 2048, lane, g2);
#pragma unroll
        for (int e = 0; e < 16; ++e) xv.v[e] += g2.v[e] * yv.v[e] * rs;
        float s2 = 0.f;
#pragma unroll
        for (int e = 0; e < 16; ++e) s2 += xv.v[e] * xv.v[e];
        const float rs2 = __builtin_amdgcn_rsqf(wave_sum(s2) * (1.f / D) + EPS);
        Row16 g1, sh; ld_row_f32(WSP(float, WS_MODV) + ((size_t)1 * 5 + 4) * 3072 + 1024, lane, g1); ld_row_f32(WSP(float, WS_MODV) + ((size_t)1 * 5 + 4) * 3072, lane, sh);
#pragma unroll
        for (int e = 0; e < 16; ++e) xv.v[e] = xv.v[e] * rs2 * g1.v[e] + sh.v[e];
        st_row_bf16(XN + (size_t)(ML + cr) * D, lane, xv);
    }
}

__global__ void __launch_bounds__(512, 2) fwd_mega(Args args) {
    extern __shared__ __attribute__((aligned(16))) unsigned char lds_raw[];
    Frame F;
    F.lds = (LAS unsigned char*)lds_raw;
    F.tid = threadIdx.x; F.lane = F.tid & 63; F.wave = __builtin_amdgcn_readfirstlane(F.tid >> 6); F.G = gridDim.x; F.bid = blockIdx.x;
    F.a = (const __attribute__((address_space(4))) Args*)__builtin_amdgcn_kernarg_segment_ptr();
    F.out = args.out; F.ws = args.ws;
    volatile LAS unsigned* MISC = (volatile LAS unsigned*)(F.lds + LDS_MISC);
    if (F.tid < 64) MISC[F.tid] = 0u;
    __syncthreads();
    XcdBarrier bar = xcd_barrier_post((unsigned*)(F.ws + WS_CTL) + 4096, MISC + 8);
    const int lo = args.ph_lo, hi = args.ph_hi;
    int ph = 0;
#ifdef TS_A
    if (F.bid == 0 && threadIdx.x == 0) ((unsigned long long*)(F.ws + WS_CTL + 512 * 1024))[0] = __builtin_amdgcn_s_memrealtime();
#endif
#define RELAUNDER() { int t_ = threadIdx.x; asm volatile("" : "+v"(t_)); F.tid = t_; F.lane = t_ & 63; F.wave = __builtin_amdgcn_readfirstlane(t_ >> 6); \
        const __attribute__((address_space(4))) Args* a_ = (const __attribute__((address_space(4))) Args*)__builtin_amdgcn_kernarg_segment_ptr(); asm volatile("" : "+s"(a_)); F.a = a_; F.ws = a_->ws; F.out = a_->out; }
#define PHASE_BEGIN if (ph >= lo && ph < hi) { RELAUNDER()
#ifdef TS_ARR
#define TS_ARRIVE() TS_MARK(40 + ph)
#else
#define TS_ARRIVE() do { } while (0)
#endif
#define PHASE_END   TS_ARRIVE(); if (ph + 1 < hi) xcd_barrier(bar); TS_REC(); } ++ph;
#ifndef REP_P0
#define REP_P0 1
#endif
#ifndef REP_A
#define REP_A 1
#endif
#ifndef REP_B
#define REP_B 1
#endif
#ifndef REP_C1
#define REP_C1 1
#endif
#ifndef REP_C2
#define REP_C2 1
#endif

    PHASE_BEGIN
        p0_prologue(F);
#if defined(TS_MP) && TS_MP == 90
        TS_MARK(90);
#endif
        RELAUNDER()
        flag_wait((unsigned*)(F.ws + WS_CTL) + 12352, 64u);
        fold_phase(F);
#if defined(TS_MP) && TS_MP == 91
        TS_MARK(91);
#endif
        RELAUNDER()
        flag_wait((unsigned*)(F.ws + WS_CTL) + 12288, 96u);
        row_phase(F, 0);
#if defined(TS_MP) && TS_MP == 92
        TS_MARK(92);
#endif
    PHASE_END
    for (int layer = 0; layer < 2; ++layer) {
        PHASE_BEGIN for (int rep = 0; rep < REP_A; ++rep) {
            const int GL = layer == 0 ? F.G : F.G - 16;
            EpiIn E{F.ws};
            if (F.bid < GL) {
                pg8::Gemm g{WSP(bf16, WS_XN), WSP(bf16, WS_BTIN) + (size_t)layer * NIN * D, D, D};
#if defined(TS_MG)
                if (layer == 0) g.ts = (unsigned long long*)(F.ws + WS_CTL + 512 * 1024);
#endif
                SchedA S{GL, F.bid, layer};
                pg8::gemm_phase(F.lds, g, S, E);
            } else {
                const int j = F.bid - GL, p = j >> 2, q = j & 3;
                unsigned* pc = (unsigned*)(F.ws + WS_CTL) + 8192 + 64 * p + 1024 * rep;
                {
                    pg8::Gemm g{WSP(bf16, WS_XN), WSP(bf16, WS_BTCAT), D, D};
                    SchedTile S{64 + p, q, 1}; EpiC1 E1{WSP(bf16, WS_MERGEDC) - (size_t)ML * 1024, WSP(unsigned char, WS_S)};
                    pg8::gemm_phase(F.lds, g, S, E1); }
                panel_sync(pc, 4u);
                {
                    pg8::Gemm g{WSP(bf16, WS_MERGEDC) - (size_t)ML * 1024, WSP(bf16, WS_BTOUT), D, D};
                    SchedTile S{64 + p, q, 0}; EpiC2 E2{WSP(bf16, WS_YC) - (size_t)ML * 1024, WSP(float, WS_SSQ)};
                    pg8::gemm_phase(F.lds, g, S, E2); }
                panel_sync(pc, 8u);
                ctx_rows(F, p, q);
                panel_sync(pc, 12u);
                {
                    pg8::Gemm g{WSP(bf16, WS_XN), WSP(bf16, WS_BTIN) + (size_t)NIN * D, D, D};
                    SchedTile S{64 + p, 2 + q, 0};
                    if (q < 2) pg8::gemm_phase(F.lds, g, S, E); else { EpiV EV{F.ws}; pg8::gemm_phase<true>(F.lds, g, S, EV); } }
            } }
        PHASE_END
        PHASE_BEGIN for (int rep = 0; rep < REP_B; ++rep) {
#ifndef B_MASK
#define B_MASK 31
#endif
#ifndef REP_ATT
#define REP_ATT 1
#endif
#ifndef REP_FOUR
#define REP_FOUR 1
#endif
#ifndef REP_CONV
#define REP_CONV 1
#endif
            const int rbw = F.bid & 15, iw = F.bid >> 4;
            const int cj = layer != 0 ? -1 : (rbw == 0 ? (iw >= 4 ? iw - 4 : -1) : (rbw == 8 ? 12 + iw : ((rbw == 4 && iw < 4) ? 28 + iw : -1)));
            FourPre fp;
            if (B_MASK & 1) { AttnPre pa{}, pb{};
                attn_pre(F, F.bid, layer, pa);
                const int nu = cj >= 0 ? 3 : 2;
#pragma unroll 1
                for (int k = 0; k + 1 < nu; ++k) { const int u = F.bid + 256 * k, un = k == 1 ? 512 + cj : F.bid + 256;
                    attn_unit<false>(F, u, layer, pa, un, pb, -1, fp); pa = pb; }
                attn_unit<true>(F, nu == 3 ? 512 + cj : F.bid + 256, layer, pa, -1, pb, F.bid, fp); }
            else four_pre(F, F.bid, fp);
#if defined(TS_MB) && TS_MB == 30
            TS_MARK(30 + 5 * layer);
#endif
            RELAUNDER()
            if (B_MASK & 2) four_item(F, F.bid, fp);
#if defined(TS_MB) && TS_MB == 31
            TS_MARK(31 + 5 * layer);
#endif
            RELAUNDER()
            if (B_MASK & 4) for (int r2 = 0; r2 < REP_CONV; ++r2) for (int it = F.bid; it < 256; it += F.G) conv_item(F, it, layer);
#if defined(TS_MB) && TS_MB == 32
            TS_MARK(32 + 5 * layer);
#endif
            RELAUNDER()
            if ((B_MASK & 24) && layer == 0) {
                if ((B_MASK & 16) && rbw == 15) conv_item(F, 256 + iw, layer);
                if ((B_MASK & 8) && rbw == 0 && iw < 4) {
                    pg8::Gemm g{WSP(bf16, WS_DCTX), WSP(bf16, WS_ZT), 512, 512};
                    SchedFc S{iw}; EpiFc E{WSP(bf16, WS_XN), WSP(bf16, WS_GF)};
                    pg8::gemm_phase(F.lds, g, S, E);
                }
            } }
        PHASE_END
        PHASE_BEGIN
            if (F.bid < 256) {
                int pm, pn; pg8::tile_of(F.bid, 64, 4, pm, pn);
                unsigned* pc = (unsigned*)(F.ws + WS_CTL) + 16384 + layer * 4096 + pm * 64;
                {   pg8::Gemm g{WSP(bf16, WS_XN), WSP(bf16, WS_BTCAT) + (size_t)layer * D * D, D, D}; g.A2 = WSP(bf16, WS_AFL);
                    SchedTile S{pm, pn, 1}; EpiC1 E{WSP(bf16, WS_MERGED), WSP(unsigned char, WS_S)};
                    pg8::gemm_phase<false, true>(F.lds, g, S, E); }
#if defined(TS_MC) && TS_MC == 21
                if (layer == 0) TS_MARK(21);
#endif
                panel_sync(pc, 4u);
#if defined(TS_MC) && TS_MC == 22
                if (layer == 0) TS_MARK(22);
#endif
                {   pg8::Gemm g{WSP(bf16, WS_MERGED), WSP(bf16, WS_BTOUT) + (size_t)layer * D * D, D, D};
                    SchedTile S{pm, pn, 0}; EpiC2 E{WSP(bf16, WS_Y), WSP(float, WS_SSQ)};
                    pg8::gemm_phase(F.lds, g, S, E); }
#if defined(TS_MC) && TS_MC == 23
                if (layer == 0) TS_MARK(23);
#endif
                panel_sync(pc, 8u);
#if defined(TS_MC) && TS_MC == 24
                if (layer == 0) TS_MARK(24);
#endif
                RELAUNDER()
                row_run(F, layer + 1, pm >> 4, pm * 256 + 64 * pn + 8 * F.wave, 1, 8);
#if defined(TS_MC) && TS_MC == 25
                if (layer == 0) TS_MARK(25);
#endif
            }
        PHASE_END
    }
}
#ifndef PH_HI
#define PH_HI 7
#endif
constexpr int N_PHASES = PH_HI;

extern "C" void kernel_launch(void* const* d_in, const int* in_sizes, int n_in, void* d_out, int out_size, void* d_ws, size_t ws_size, hipStream_t stream) {
    static int grid = 0;
    if (grid == 0) {
        int dev = 0, cus = 0, per_cu = 0;
        if (n_in != 20 || ws_size < WS_END) { fprintf(stderr, "kernel_launch: unexpected n_in %d / ws %zu\n", n_in, ws_size); grid = -1; return; }
        hipGetDevice(&dev); hipDeviceGetAttribute(&cus, hipDeviceAttributeMultiprocessorCount, dev);
        if (hipFuncSetAttribute((const void*)fwd_mega, hipFuncAttributeMaxDynamicSharedMemorySize, LDS_BYTES) != hipSuccess) { fprintf(stderr, "kernel_launch: hipFuncSetAttribute failed\n"); grid = -1; return; }
        hipOccupancyMaxActiveBlocksPerMultiprocessor(&per_cu, (const void*)fwd_mega, 512, LDS_BYTES);
        (void)hipGetLastError();
        if (per_cu < 1) { fprintf(stderr, "kernel_launch: occupancy query says %d blocks/CU\n", per_cu); grid = -1; return; }
        if (cus < 256) { fprintf(stderr, "kernel_launch: built for a 256-CU device, found %d CUs\n", cus); grid = -1; return; }
        grid = 256;
    }
    if (grid < 0) return;
    hipMemsetAsync((char*)d_ws + WS_CTL, 0, 1 * MiB, stream);
    Args a{};
    for (int i = 0; i < 20; ++i) a.in[i] = (const float*)d_in[i];
    a.out = (float*)d_out; a.ws = (unsigned char*)d_ws; a.ph_lo = 0; a.ph_hi = N_PHASES;
    hipLaunchKernelGGL(fwd_mega, dim3(grid), dim3(512), LDS_BYTES, stream, a);
}
```
